# Optimizing an MI355X kernel written in HIP

```python
import jax, jax.numpy as jnp
from jax import lax
import numpy as np

D_MODEL = 1024
BATCH = 2
SEQ = 16384
DEPTH = 4

N_HEADS_A = 8
HEAD_DIM = 64
D_ATTN = N_HEADS_A * HEAD_DIM
DILATED_BRANCHES = ((128, 1), (512, 4), (2048, 16))
MAX_WINDOW = 2048
Q_BLOCK = 128
POOL_WINDOWS = (2, 4, 8, 16)
N_POOL_GROUPS = 4
D_POOL = D_MODEL // 2
POOL_GROUP_DIM = D_POOL // N_POOL_GROUPS
D_MIX_EVEN = D_ATTN + D_POOL
D_IN_EVEN = 3 * D_ATTN + D_POOL
D_CONV = D_MODEL
CONV_WIDTH = 3
PEER_HEADS = 8
PEER_N_KEYS = 128
PEER_N_EXPERTS = PEER_N_KEYS * PEER_N_KEYS
PEER_TOPK = 16
PEER_D_KEY = 256
PEER_HALF = PEER_D_KEY // 2
TOKEN_CHUNK = 128
N_EVEN = (DEPTH + 1) // 2
N_ODD = DEPTH // 2
EPS = 1e-6

kernel_name = "hybrid_dilated_pool_conv_peer_trunk"


def rms_norm(x, g):
    x32 = x.astype(jnp.float32)
    y = x32 * lax.rsqrt(jnp.mean(x32 * x32, axis=-1, keepdims=True) + EPS)
    return (y * g.astype(jnp.float32)).astype(x.dtype)


def dilated_sliding_attention(q, k, v):
    b, s, h, hd = q.shape
    n_blocks = s // Q_BLOCK
    pad = ((0, 0), (MAX_WINDOW, 0), (0, 0), (0, 0))
    kp = jnp.pad(k, pad)
    vp = jnp.pad(v, pad)
    qi = jnp.arange(Q_BLOCK)
    scale = HEAD_DIM ** -0.5

    def block(i):
        s0 = i * Q_BLOCK
        qb = lax.dynamic_slice_in_dim(q, s0, Q_BLOCK, axis=1).astype(jnp.float32)
        outs, lses = [], []
        for window, dil in DILATED_BRANCHES:
            j = jnp.arange(window // dil + 1)
            pos = s0 + qi[:, None] - dil * j[None, :]
            idx = pos + MAX_WINDOW
            kg = kp[:, idx].astype(jnp.float32)
            vg = vp[:, idx].astype(jnp.float32)
            sc = jnp.einsum('bqhd,bqjhd->bqhj', qb, kg) * scale
            sc = jnp.where((pos >= 0)[None, :, None, :], sc, -jnp.inf)
            m = jnp.max(sc, axis=-1, keepdims=True)
            p = jnp.exp(sc - m)
            den = jnp.sum(p, axis=-1, keepdims=True)
            outs.append(jnp.einsum('bqhj,bqjhd->bqhd', p, vg) / den)
            lses.append(m[..., 0] + jnp.log(den[..., 0]))
        w = jax.nn.softmax(jnp.stack(lses, axis=-1), axis=-1)
        o = jnp.sum(w[..., None] * jnp.stack(outs, axis=3), axis=3)
        return o.astype(v.dtype)

    out = lax.map(block, jnp.arange(n_blocks))
    return out.transpose(1, 0, 2, 3, 4).reshape(b, s, h * hd)


def multiscale_pool(u, pool_w, pool_scale):
    b, s, _ = u.shape
    ug = u.reshape(b, s, N_POOL_GROUPS, POOL_GROUP_DIM)
    cs0 = jnp.pad(jnp.cumsum(ug.astype(jnp.float32), axis=1), ((0, 0), (1, 0), (0, 0), (0, 0)))
    t1 = jnp.arange(1, s + 1, dtype=jnp.float32)
    pooled = []
    for gi, w in enumerate(POOL_WINDOWS):
        cg = cs0[:, :, gi]
        upper = cg[:, 1:]
        lower = jnp.pad(cg, ((0, 0), (w - 1, 0), (0, 0)))[:, :s]
        cnt = jnp.minimum(t1, float(w))[None, :, None]
        pooled.append((upper - lower) / cnt)
    pooled = jnp.stack(pooled, axis=2)
    diff = (pooled - ug.astype(jnp.float32)).astype(u.dtype)
    y = jnp.einsum('bsgc,gcd->bsgd', diff, pool_w)
    return y.reshape(b, s, D_POOL) * pool_scale


def short_gated_conv(h, w_in, conv_w, w_out):
    s = h.shape[1]
    xin, gate_b, gate_c = jnp.split(h @ w_in, 3, axis=-1)
    u = gate_c * xin
    up = jnp.pad(u, ((0, 0), (CONV_WIDTH - 1, 0), (0, 0)))
    y = conv_w[0] * up[:, CONV_WIDTH - 1:CONV_WIDTH - 1 + s]
    for lag in range(1, CONV_WIDTH):
        y = y + conv_w[lag] * up[:, CONV_WIDTH - 1 - lag:CONV_WIDTH - 1 - lag + s]
    return (gate_b * y) @ w_out


def peer_ffn(h, w_q, key1, key2, u_tab, v_tab):
    b, s, d = h.shape
    hc = h.reshape((b * s) // TOKEN_CHUNK, TOKEN_CHUNK, d)

    def chunk(xc):
        q = (xc @ w_q).reshape(TOKEN_CHUNK, PEER_HEADS, PEER_D_KEY).astype(jnp.float32)
        s1 = jnp.einsum('thc,nc->thn', q[..., :PEER_HALF], key1.astype(jnp.float32))
        s2 = jnp.einsum('thc,nc->thn', q[..., PEER_HALF:], key2.astype(jnp.float32))
        v1, i1 = lax.top_k(s1, PEER_TOPK)
        v2, i2 = lax.top_k(s2, PEER_TOPK)
        cand = (v1[..., :, None] + v2[..., None, :]).reshape(TOKEN_CHUNK, PEER_HEADS, PEER_TOPK * PEER_TOPK)
        vs, ci = lax.top_k(cand, PEER_TOPK)
        e1 = jnp.take_along_axis(i1, ci // PEER_TOPK, axis=-1)
        e2 = jnp.take_along_axis(i2, ci % PEER_TOPK, axis=-1)
        expert = e1 * PEER_N_KEYS + e2
        g = jax.nn.softmax(vs, axis=-1)
        act = jax.nn.gelu(jnp.einsum('td,thkd->thk', xc, u_tab[expert]), approximate=False)
        return jnp.einsum('thk,thkd->td', (g * act).astype(xc.dtype), v_tab[expert])

    return lax.map(chunk, hc).reshape(b, s, d)


def setup_inputs(seed: int = 0) -> dict:
    key = jax.random.key(seed)
    ks = jax.random.split(key, 24)
    f32 = jnp.float32

    def nrm(k, shape, scale):
        return jax.random.normal(k, shape, f32) * scale

    D = D_MODEL
    return {
        "x": nrm(ks[0], (BATCH, SEQ, D), 1.0),
        "c": nrm(ks[1], (BATCH, D), 1.0),
        "ada_w": nrm(ks[2], (DEPTH, D, 6 * D), D ** -0.5),
        "ada_b": nrm(ks[3], (DEPTH, 6 * D), 0.02),
        "norm_mix_g": 1.0 + nrm(ks[4], (DEPTH, D), 0.02),
        "norm_ffn_g": 1.0 + nrm(ks[5], (DEPTH, D), 0.02),
        "ab_w_in": nrm(ks[6], (N_EVEN, D, D_IN_EVEN), D ** -0.5),
        "ab_q_gain": 1.0 + nrm(ks[7], (N_EVEN, N_HEADS_A, HEAD_DIM), 0.02),
        "ab_k_gain": 1.0 + nrm(ks[8], (N_EVEN, N_HEADS_A, HEAD_DIM), 0.02),
        "pool_w": nrm(ks[9], (N_EVEN, N_POOL_GROUPS, POOL_GROUP_DIM, POOL_GROUP_DIM), POOL_GROUP_DIM ** -0.5),
        "pool_scale": 1.0 + nrm(ks[10], (N_EVEN, D_POOL), 0.1),
        "ab_w_out": nrm(ks[11], (N_EVEN, D_MIX_EVEN, D), D_MIX_EVEN ** -0.5),
        "conv_w_in": nrm(ks[12], (N_ODD, D, 3 * D_CONV), D ** -0.5),
        "conv_w": nrm(ks[13], (N_ODD, CONV_WIDTH, D_CONV), CONV_WIDTH ** -0.5),
        "conv_w_out": nrm(ks[14], (N_ODD, D_CONV, D), D_CONV ** -0.5),
        "peer_w_q": nrm(ks[15], (DEPTH, D, PEER_HEADS * PEER_D_KEY), D ** -0.5),
        "peer_key1": nrm(ks[16], (DEPTH, PEER_N_KEYS, PEER_HALF), PEER_HALF ** -0.5),
        "peer_key2": nrm(ks[17], (DEPTH, PEER_N_KEYS, PEER_HALF), PEER_HALF ** -0.5),
        "peer_u": nrm(ks[18], (DEPTH, PEER_N_EXPERTS, D), D ** -0.5),
        "peer_v": nrm(ks[19], (DEPTH, PEER_N_EXPERTS, D), PEER_TOPK ** -0.5),
    }


def reference(x, c, ada_w, ada_b, norm_mix_g, norm_ffn_g, ab_w_in, ab_q_gain, ab_k_gain,
              pool_w, pool_scale, ab_w_out, conv_w_in, conv_w, conv_w_out,
              peer_w_q, peer_key1, peer_key2, peer_u, peer_v):
    b, s, _ = x.shape
    c_act = jax.nn.silu(c)
    for layer in range(DEPTH):
        mod = c_act @ ada_w[layer] + ada_b[layer]
        sh1, sc1, g1, sh2, sc2, g2 = [m[:, None, :] for m in jnp.split(mod, 6, axis=-1)]
        h = rms_norm(x, norm_mix_g[layer]) * (1.0 + sc1) + sh1
        if layer % 2 == 0:
            e = layer // 2
            proj = h @ ab_w_in[e]
            q, k, v, u = jnp.split(proj, [D_ATTN, 2 * D_ATTN, 3 * D_ATTN], axis=-1)
            q = rms_norm(q.reshape(b, s, N_HEADS_A, HEAD_DIM), ab_q_gain[e])
            k = rms_norm(k.reshape(b, s, N_HEADS_A, HEAD_DIM), ab_k_gain[e])
            v = v.reshape(b, s, N_HEADS_A, HEAD_DIM)
            y_attn = dilated_sliding_attention(q, k, v)
            y_pool = multiscale_pool(u, pool_w[e], pool_scale[e])
            y = jnp.concatenate([y_attn, y_pool], axis=-1) @ ab_w_out[e]
        else:
            o = layer // 2
            y = short_gated_conv(h, conv_w_in[o], conv_w[o], conv_w_out[o])
        x = x + g1 * y
        h = rms_norm(x, norm_ffn_g[layer]) * (1.0 + sc2) + sh2
        x = x + g2 * peer_ffn(h, peer_w_q[layer], peer_key1[layer], peer_key2[layer],
                              peer_u[layer], peer_v[layer])
    return x
```

```cpp
#include <hip/hip_runtime.h>
#include <hip/hip_cooperative_groups.h>
#include <cstdio>
namespace cg = cooperative_groups;
__device__ __forceinline__ int mk_tid() { int t = threadIdx.x; asm volatile("" : "+v"(t)); return t; }
__device__ __forceinline__ int mk_bid() { int t = blockIdx.x; asm volatile("" : "+s"(t)); return t; }
__device__ __forceinline__ int mk_grid() { int t = gridDim.x; asm volatile("" : "+s"(t)); return t; }
namespace pg8 {
#define PG8_LAS __attribute__((address_space(3)))
typedef unsigned short bf16_t;
typedef short bf16x8 __attribute__((ext_vector_type(8)));
typedef float f32x4 __attribute__((ext_vector_type(4)));
typedef unsigned u32x4 __attribute__((ext_vector_type(4)));
constexpr int BM = 256, BK = 64, HALF = 128, HTB = HALF * BK * 2  , STAGE_BYTES = 8 * HTB, NXCD = 8, WGM = 8;

__host__ __device__ __forceinline__ int lds_byte(int r, int c) { const int st = (r >> 4) * 2 + (c >> 5), rr = r & 15, cc = c & 31, ob = rr * 64 + cc * 2; return st * 1024 + (ob ^ (((ob >> 9) & 1) << 5)); }
__host__ __device__ __forceinline__ void stage_rc(int b, int& R, int& C) { const int st = b / 1024, sb = b % 1024, swz = sb ^ (((sb >> 9) & 1) << 5); R = (st >> 1) * 16 + swz / 64; C = (st & 1) * 32 + (swz % 64) / 2; }
__host__ __device__ __forceinline__ int perm32(int rho) { const int n = rho >> 4, i = rho & 15; return 8 * (i >> 2) + 4 * n + (i & 3); }

struct Unit { int pm, pn; };
struct Gemm { const bf16_t* A; const bf16_t* Bt; int M, N, K; };

struct StaticOrder {
    int nM, nN, nwg, G, c;
    __host__ __device__ void init(int M, int N, int G_, int c_) { nM = M / BM; nN = N / BM; nwg = nM * nN; G = G_; c = c_; }
    __host__ __device__ bool next(int i, Unit& u) const {
        const long L = (long)i * G + c; if (L >= nwg) return false;
        int wgid = (int)L; { const int q = nwg / NXCD, r = nwg % NXCD, xcd = wgid % NXCD, off = wgid / NXCD; wgid = (xcd < r ? xcd * (q + 1) : r * (q + 1) + (xcd - r) * q) + off; }
        const int nig = WGM * nN, gid = wgid / nig, fm = gid * WGM, gsz = (nM - fm) < WGM ? (nM - fm) : WGM;
        u.pm = fm + ((wgid % nig) % gsz); u.pn = (wgid % nig) / gsz; return true;
    }
    __device__ __forceinline__ void a_ready(const Unit&) const {}
    __device__ __forceinline__ void done(const Unit&) const {}
};


template <class Epi, class Sched, bool ALIGN_EPI = false, bool SP2 = false>
__device__ __forceinline__ void gemm_phase(PG8_LAS unsigned char* lds, const Gemm g, const Sched& S, const Epi& E) {
    const int tid = mk_tid(), wid = __builtin_amdgcn_readfirstlane(tid >> 6), lane = tid & 63, wr = wid >> 2, wc = wid & 3, fr = lane & 15, fq = lane >> 4;
    const int K = g.K, nt = K / BK;
    unsigned voffA[2], voffB[2];
#pragma unroll
    for (int i = 0; i < 2; ++i) { int R, C; stage_rc(tid * 16 + i * 8192, R, C); const int Rb = Epi::PERM ? ((R & ~31) + perm32(R & 31)) : R;
        voffA[i] = (unsigned)(R * K + C) * 2u; voffB[i] = (unsigned)(Rb * K + C) * 2u; }
    const size_t kstep = (size_t)(BK * 2);
    const size_t hstep = (size_t)HALF * K * 2;
    const size_t tstep = 2 * hstep;
    const unsigned ldsw = (unsigned)wid * 1024u;
    const int aoff = lds_byte(wr * 64 + fr, fq * 8), boff = lds_byte(wc * 32 + fr, fq * 8);
#define PG8_SA(b, h) (((b) * 2 + (h)) * HTB)
#define PG8_SB(b, h) ((4 + (b) * 2 + (h)) * HTB)
#define PG8_STAGE(bufoff, gbase, voff) do { _Pragma("unroll") for (int _i = 0; _i < 2; ++_i) \
        __builtin_amdgcn_global_load_lds((const unsigned*)((const char*)(gbase) + (voff)[_i]), (PG8_LAS unsigned*)(lds + (bufoff) + ldsw + _i * 8192), 16, 0, 0); } while (0)
#define PG8_LDA(dst, b, h) do { _Pragma("unroll") for (int m = 0; m < 4; ++m) _Pragma("unroll") for (int k = 0; k < 2; ++k) dst[m][k] = *(const PG8_LAS bf16x8*)(lds + PG8_SA(b, h) + aoff + m * 2048 + k * 1024); } while (0)
#define PG8_LDB(dst, b, h) do { _Pragma("unroll") for (int n = 0; n < 2; ++n) _Pragma("unroll") for (int k = 0; k < 2; ++k) dst[n][k] = *(const PG8_LAS bf16x8*)(lds + PG8_SB(b, h) + boff + n * 2048 + k * 1024); } while (0)
#define PG8_MMA(ai, bj, At, Bt) do { __builtin_amdgcn_s_setprio(1); _Pragma("unroll") for (int m = 0; m < 4; ++m) _Pragma("unroll") for (int n = 0; n < 2; ++n) _Pragma("unroll") for (int k = 0; k < 2; ++k) \
        acc[ai][bj][m][n] = __builtin_amdgcn_mfma_f32_16x16x32_bf16(Bt[n][k], At[m][k], acc[ai][bj][m][n], 0, 0, 0); __builtin_amdgcn_s_setprio(0); } while (0)
#define PG8_WAIT_V(n) asm volatile("s_waitcnt vmcnt(" #n ")" ::: "memory")
#define PG8_WAIT_L(n) asm volatile("s_waitcnt lgkmcnt(" #n ")" ::: "memory")
#define PG8_BAR __builtin_amdgcn_s_barrier()
#define PG8_SCHED __builtin_amdgcn_sched_barrier(0)
    Unit cur, nxt; int ui = 0;
    if (!S.next(0, cur)) return;
    f32x4 acc[2][2][4][2];
#pragma unroll
    for (int a = 0; a < 2; ++a)
#pragma unroll
        for (int b = 0; b < 2; ++b)
#pragma unroll
            for (int m = 0; m < 4; ++m)
#pragma unroll
                for (int n = 0; n < 2; ++n) acc[a][b][m][n] = (f32x4){0.f, 0.f, 0.f, 0.f};
    bf16x8 At[4][2], B0[2][2], B1[2][2];
    const char* cA = (const char*)g.A + (size_t)cur.pm * tstep; const char* cB = (const char*)g.Bt + (size_t)cur.pn * tstep;
    S.a_ready(cur);
    if constexpr (SP2) {
        PG8_STAGE(PG8_SB(0, 0), cB, voffB); PG8_STAGE(PG8_SB(0, 1), cB + hstep, voffB); PG8_STAGE(PG8_SA(0, 0), cA, voffA); PG8_STAGE(PG8_SA(0, 1), cA + hstep, voffA);
        if (wr == 1) PG8_BAR;
        PG8_WAIT_V(2); PG8_BAR;
        PG8_STAGE(PG8_SB(1, 0), cB + kstep, voffB); PG8_STAGE(PG8_SA(1, 0), cA + kstep, voffA); PG8_STAGE(PG8_SB(1, 1), cB + hstep + kstep, voffB);
        PG8_WAIT_V(6); PG8_BAR;
    } else {
        PG8_STAGE(PG8_SB(0, 0), cB, voffB); PG8_STAGE(PG8_SA(0, 0), cA, voffA); PG8_STAGE(PG8_SB(0, 1), cB + hstep, voffB); PG8_STAGE(PG8_SA(0, 1), cA + hstep, voffA);
        if (wr == 1) PG8_BAR;
        PG8_WAIT_V(4); PG8_BAR;
        PG8_STAGE(PG8_SB(1, 0), cB + kstep, voffB); PG8_STAGE(PG8_SA(1, 0), cA + kstep, voffA); PG8_STAGE(PG8_SB(1, 1), cB + hstep + kstep, voffB);
        PG8_WAIT_V(6); PG8_BAR;
    }
    for (;;) {
        const bool has_next = S.next(ui + 1, nxt);
        const char* nA = has_next ? (const char*)g.A + (size_t)nxt.pm * tstep : cA; const char* nB = has_next ? (const char*)g.Bt + (size_t)nxt.pn * tstep : cB;
        for (int t = 0; t < nt; t += 2) {
            const bool last = (t == nt - 2);
            const char* a1 = cA + (size_t)(t + 1) * kstep;
            const char* a2 = last ? nA : cA + (size_t)(t + 2) * kstep; const char* b2 = last ? nB : cB + (size_t)(t + 2) * kstep;
            const char* a3 = a2 + kstep; const char* b3 = b2 + kstep;
            if (last && has_next) S.a_ready(nxt);
            if constexpr (SP2) {
            PG8_LDB(B0, 0, 0); PG8_LDB(B1, 0, 1); PG8_SCHED; PG8_LDA(At, 0, 0); PG8_STAGE(PG8_SA(1, 1), a1 + hstep, voffA);
            PG8_WAIT_V(8); PG8_WAIT_L(0); PG8_BAR; PG8_MMA(0, 0, At, B0); PG8_MMA(0, 1, At, B1); PG8_BAR; PG8_SCHED;
            PG8_LDA(At, 0, 1); PG8_STAGE(PG8_SB(0, 0), b2, voffB); PG8_STAGE(PG8_SB(0, 1), b2 + hstep, voffB); PG8_STAGE(PG8_SA(0, 0), a2, voffA);
            PG8_WAIT_V(8); PG8_WAIT_L(0); PG8_BAR; PG8_MMA(1, 0, At, B0); PG8_MMA(1, 1, At, B1); PG8_BAR; PG8_SCHED;
            PG8_LDB(B0, 1, 0); PG8_LDB(B1, 1, 1); PG8_SCHED; PG8_LDA(At, 1, 0); PG8_STAGE(PG8_SA(0, 1), a2 + hstep, voffA);
            PG8_WAIT_V(8); PG8_WAIT_L(0); PG8_BAR; PG8_MMA(0, 0, At, B0); PG8_MMA(0, 1, At, B1); PG8_BAR; PG8_SCHED;
            PG8_LDA(At, 1, 1); PG8_STAGE(PG8_SB(1, 0), b3, voffB); PG8_STAGE(PG8_SB(1, 1), b3 + hstep, voffB); PG8_STAGE(PG8_SA(1, 0), a3, voffA);
            PG8_WAIT_V(8); PG8_WAIT_L(0); PG8_BAR; PG8_MMA(1, 0, At, B0); PG8_MMA(1, 1, At, B1); PG8_BAR; PG8_SCHED;
            } else {
            PG8_LDB(B0, 0, 0); PG8_SCHED; PG8_LDA(At, 0, 0); PG8_STAGE(PG8_SA(1, 1), a1 + hstep, voffA);
            PG8_WAIT_L(8); PG8_BAR; PG8_WAIT_L(0); PG8_MMA(0, 0, At, B0); PG8_BAR; PG8_SCHED;
            PG8_LDB(B1, 0, 1); PG8_STAGE(PG8_SB(0, 0), b2, voffB);
            PG8_BAR; PG8_WAIT_L(0); PG8_MMA(0, 1, At, B1); PG8_BAR;
            PG8_LDA(At, 0, 1); PG8_STAGE(PG8_SA(0, 0), a2, voffA);
            PG8_BAR; PG8_WAIT_L(0); PG8_MMA(1, 0, At, B0); PG8_BAR; PG8_SCHED;
            PG8_STAGE(PG8_SB(0, 1), b2 + hstep, voffB);
            PG8_WAIT_V(6); PG8_BAR; PG8_MMA(1, 1, At, B1); PG8_BAR;
            PG8_LDB(B0, 1, 0); PG8_SCHED; PG8_LDA(At, 1, 0); PG8_STAGE(PG8_SA(0, 1), a2 + hstep, voffA);
            PG8_WAIT_L(8); PG8_BAR; PG8_WAIT_L(0); PG8_MMA(0, 0, At, B0); PG8_BAR; PG8_SCHED;
            PG8_LDB(B1, 1, 1); PG8_STAGE(PG8_SB(1, 0), b3, voffB);
            PG8_BAR; PG8_WAIT_L(0); PG8_MMA(0, 1, At, B1); PG8_BAR;
            PG8_LDA(At, 1, 1); PG8_STAGE(PG8_SA(1, 0), a3, voffA);
            PG8_BAR; PG8_WAIT_L(0); PG8_MMA(1, 0, At, B0); PG8_BAR; PG8_SCHED;
            PG8_STAGE(PG8_SB(1, 1), b3 + hstep, voffB);
            PG8_WAIT_V(6); PG8_BAR; PG8_MMA(1, 1, At, B1); PG8_BAR;
            }
        }
        if constexpr (ALIGN_EPI) { if (wr == 0) PG8_BAR; }
        if constexpr (!Epi::AFTER_DRAIN) { E(acc, cur, wr, wc, fr, fq); S.done(cur); }
        if (!has_next) break;
#pragma unroll
        for (int a = 0; a < 2; ++a)
#pragma unroll
            for (int b = 0; b < 2; ++b)
#pragma unroll
                for (int m = 0; m < 4; ++m)
#pragma unroll
                    for (int n = 0; n < 2; ++n) acc[a][b][m][n] = (f32x4){0.f, 0.f, 0.f, 0.f};
        cur = nxt; cA = nA; cB = nB; ++ui;
        if constexpr (ALIGN_EPI) { if (wr == 1) PG8_BAR; }
    }
    PG8_WAIT_V(0);
    if constexpr (!ALIGN_EPI) { if (wr == 0) PG8_BAR; }
    PG8_BAR;
    if constexpr (Epi::AFTER_DRAIN) { E.fused(acc, cur, wr, wc, fr, fq, lds, wid, lane); S.done(cur); }
#undef PG8_SA
#undef PG8_SB
#undef PG8_STAGE
#undef PG8_LDA
#undef PG8_LDB
#undef PG8_MMA
#undef PG8_WAIT_V
#undef PG8_WAIT_L
#undef PG8_BAR
#undef PG8_SCHED
}
}
using pg8::bf16_t; using pg8::bf16x8; using pg8::f32x4; using pg8::u32x4; using pg8::Unit;
#define LAS PG8_LAS
#define DI __device__ __forceinline__
typedef __bf16 bf16x2_t __attribute__((ext_vector_type(2)));
typedef float f32x2_t __attribute__((ext_vector_type(2)));
typedef float f32x16 __attribute__((ext_vector_type(16)));
typedef unsigned u32x2 __attribute__((ext_vector_type(2)));
#define MFMA32(a, b, c) __builtin_amdgcn_mfma_f32_32x32x16_bf16((a), (b), (c), 0, 0, 0)

constexpr int Dm = 1024, NBATCH = 2, SEQ = 16384, T = NBATCH * SEQ, NEXP = 16384;
constexpr float EPS = 1e-6f;
constexpr size_t MiB = 1u << 20;
constexpr size_t WS_MOD = 0, WS_KEYS = 256 * 1024, WS_WABIN = 1 * MiB, WS_WABOUT = 9 * MiB, WS_WCVIN = 13 * MiB, WS_WCVOUT = 25 * MiB, WS_WPQ = 29 * MiB,
                 WS_PU = 45 * MiB, WS_PV = 173 * MiB, WS_H = 301 * MiB, WS_BIG = 365 * MiB, WS_YCAT = 493 * MiB, WS_RIDX = 557 * MiB, WS_RGATE = 573 * MiB, WS_END = 589 * MiB,
                 WS_H8 = 589 * MiB, WS_P = 621 * MiB, WS_W = 749 * MiB, WS_HS = 765 * MiB, WS_US = 766 * MiB, WS_BAR = 767 * MiB, WS_XB = 768 * MiB, WS_END2 = 832 * MiB;
constexpr int LDS_BYTES = 131072 + 16;

DI unsigned pack2(float lo, float hi) { f32x2_t v = {lo, hi}; bf16x2_t b = __builtin_convertvector(v, bf16x2_t); return __builtin_bit_cast(unsigned, b); }
DI float bf_lo(unsigned w) { return __uint_as_float(w << 16); }
DI float bf_hi(unsigned w) { return __uint_as_float(w & 0xffff0000u); }
DI float dot2bf(unsigned a, unsigned b, float c) { return __builtin_amdgcn_fdot2_f32_bf16(__builtin_bit_cast(bf16x2_t, a), __builtin_bit_cast(bf16x2_t, b), c, false); }
DI float rdlane(float v, int l) { return __int_as_float(__builtin_amdgcn_readlane(__float_as_int(v), l)); }

struct Args { const float* in[20]; float* out; unsigned char* ws; int ph_lo, ph_hi; };

template <class Perm> DI void transpose_cvt_lds(const float* __restrict__ W, int K, int N, bf16_t* __restrict__ Bt, int ldb, Perm perm, LAS unsigned char* lds, int bidx, int G, int tid) {
    LAS unsigned short* Tl = (LAS unsigned short*)lds;
    const int nnt = N / 64, ntiles = (K / 64) * nnt;
    for (int tile = bidx; tile < ntiles; tile += G) {
        const int kt = tile / nnt, nt = tile % nnt;
        {
            const int kr = tid >> 3, nq = tid & 7, src = perm(64 * nt + 8 * nq);
            const float* p = W + (size_t)(64 * kt + kr) * N + src;
            const f32x4 v0 = *(const f32x4*)p, v1 = *(const f32x4*)(p + 4);
            const unsigned w0 = pack2(v0[0], v0[1]), w1 = pack2(v0[2], v0[3]), w2 = pack2(v1[0], v1[1]), w3 = pack2(v1[2], v1[3]);
            LAS unsigned short* q = Tl + (8 * nq) * 66 + kr;
            q[0] = (unsigned short)(w0 & 0xffffu); q[66] = (unsigned short)(w0 >> 16); q[132] = (unsigned short)(w1 & 0xffffu); q[198] = (unsigned short)(w1 >> 16);
            q[264] = (unsigned short)(w2 & 0xffffu); q[330] = (unsigned short)(w2 >> 16); q[396] = (unsigned short)(w3 & 0xffffu); q[462] = (unsigned short)(w3 >> 16);
        }
        __syncthreads();
        {
            const int nr = tid >> 3, kc = tid & 7;
            const LAS unsigned* r = (const LAS unsigned*)(Tl + nr * 66 + 8 * kc);
            u32x4 w; w.x = r[0]; w.y = r[1]; w.z = r[2]; w.w = r[3];
            *(u32x4*)(Bt + (size_t)(64 * nt + nr) * ldb + 64 * kt + 8 * kc) = w;
        }
        __syncthreads();
    }
}
struct PermId { DI int operator()(int n) const { return n; } };
struct PermAbIn { DI int operator()(int n) const { const int pn = n >> 8, ct = n & 255, bj = ct >> 7, wc = (ct >> 5) & 3, j = ct & 31; return 256 * pn + 64 * wc + 32 * bj + j; } };
struct PermCvIn { DI int operator()(int n) const { const int pn = n >> 8, ct = n & 255; if (pn < 8) return (ct < 128) ? 128 * pn + ct : 2048 + 128 * pn + (ct - 128); return 1024 + (n - 2048); } };

DI void cvt_elems(const float* __restrict__ src, bf16_t* __restrict__ dst, size_t n8, size_t gtid, size_t gthreads) {
    for (size_t it = gtid; it < n8; it += gthreads) {
        const f32x4 a = *(const f32x4*)(src + it * 8), b = *(const f32x4*)(src + it * 8 + 4);
        u32x4 w; w.x = pack2(a[0], a[1]); w.y = pack2(a[2], a[3]); w.z = pack2(b[0], b[1]); w.w = pack2(b[2], b[3]);
        *(u32x4*)(dst + it * 8) = w;
    }
}

DI unsigned quant4(f32x4 a, float inv) {
    unsigned w = 0;
    w = __builtin_amdgcn_cvt_pk_u8_f32(a[0] * inv + 128.f, 0, w); w = __builtin_amdgcn_cvt_pk_u8_f32(a[1] * inv + 128.f, 1, w);
    w = __builtin_amdgcn_cvt_pk_u8_f32(a[2] * inv + 128.f, 2, w); w = __builtin_amdgcn_cvt_pk_u8_f32(a[3] * inv + 128.f, 3, w);
    return w ^ 0x80808080u;
}
DI void cvt_u_i8(const float* __restrict__ src, unsigned char* __restrict__ dst, float* __restrict__ us, int nrows, int gwave, int nwaves, int lane) {
    for (int row = gwave; row < nrows; row += nwaves) {
        f32x4 a[4]; float am = 0.f;
#pragma unroll
        for (int q = 0; q < 4; ++q) { a[q] = *(const f32x4*)(src + (size_t)row * 1024 + 16 * lane + 4 * q); am = fmaxf(am, fmaxf(fmaxf(fabsf(a[q][0]), fabsf(a[q][1])), fmaxf(fabsf(a[q][2]), fabsf(a[q][3])))); }
#pragma unroll
        for (int o = 32; o >= 1; o >>= 1) am = fmaxf(am, __shfl_xor(am, o));
        const float inv = am > 0.f ? 127.f / am : 0.f;
        u32x4 w;
#pragma unroll
        for (int q = 0; q < 4; ++q) w[q] = quant4(a[q], inv);
        const size_t L = row >> 14, e = row & (NEXP - 1);
        *(u32x4*)(dst + ((L * 8 + (lane >> 3)) * NEXP + e) * 128 + 16 * (lane & 7)) = w;
        if (lane == 0) us[row] = am * (1.f / 127.f);
    }
}
DI void cj_issue(f32x4 (&a)[4], const float* __restrict__ pu, const float* __restrict__ pv, int L, int jr, int lane) {
    const float* src = (jr < NEXP) ? pv + ((size_t)L * NEXP + jr) * 1024 : pu + ((size_t)(L + 1) * NEXP + (jr - NEXP)) * 1024;
#pragma unroll
    for (int q = 0; q < 4; ++q) a[q] = *(const f32x4*)(src + 16 * lane + 4 * q);
}
DI void cj_finish(const f32x4 (&a)[4], unsigned char* __restrict__ dU, unsigned char* __restrict__ dV, float* __restrict__ us, int L, int jr, int lane) {
    u32x4 w;
    if (jr < NEXP) {
#pragma unroll
        for (int q = 0; q < 4; ++q) {
            const f32x4 b = a[q] * 8.f;
            int pk = __builtin_amdgcn_cvt_pk_fp8_f32(b[0], b[1], 0, false);
            pk = __builtin_amdgcn_cvt_pk_fp8_f32(b[2], b[3], pk, true);
            w[q] = (unsigned)pk;
        }
        *(u32x4*)(dV + (((size_t)L * 8 + (lane >> 3)) * NEXP + jr) * 128 + 16 * (lane & 7)) = w;
    } else {
        const int e = jr - NEXP; float am = 0.f;
#pragma unroll
        for (int q = 0; q < 4; ++q) am = fmaxf(am, fmaxf(fmaxf(fabsf(a[q][0]), fabsf(a[q][1])), fmaxf(fabsf(a[q][2]), fabsf(a[q][3]))));
#pragma unroll
        for (int o = 32; o >= 1; o >>= 1) am = fmaxf(am, __shfl_xor(am, o));
        const float inv = am > 0.f ? 127.f / am : 0.f;
#pragma unroll
        for (int q = 0; q < 4; ++q) w[q] = quant4(a[q], inv);
        *(u32x4*)(dU + (((size_t)(L + 1) * 8 + (lane >> 3)) * NEXP + e) * 128 + 16 * (lane & 7)) = w;
        if (lane == 0) us[(size_t)(L + 1) * NEXP + e] = am * (1.f / 127.f);
    }
}
DI void p0_prologue(const Args& a, LAS unsigned char* lds) {
    const int TIDX = mk_tid(), BIDX = mk_bid(), GDIM = mk_grid(); (void)TIDX; (void)BIDX; (void)GDIM;
    const int tid = TIDX, G = GDIM, gtid = BIDX * 512 + tid, gth = G * 512;
    unsigned char* ws = a.ws;
    {
        LAS float* cact = (LAS float*)lds;
        LAS float* red = (LAS float*)(lds + 8192);
        const float* c = a.in[1];
        for (int i = tid; i < 2048; i += 512) { const float v = c[i]; cact[i] = v / (1.f + __expf(-v)); }
        __syncthreads();
        for (int unit = BIDX; unit < 4 * 48; unit += G) {
            const int L = unit / 48, cg0 = (unit % 48) * 128, cq = tid & 31, kg = tid >> 5;
            const float* W = a.in[2] + (size_t)L * 1024 * 6144 + cg0 + 4 * cq;
            f32x4 s0 = {0.f, 0.f, 0.f, 0.f}, s1 = {0.f, 0.f, 0.f, 0.f};
#pragma unroll 8
            for (int k = kg * 64; k < kg * 64 + 64; ++k) {
                const f32x4 w = *(const f32x4*)(W + (size_t)k * 6144);
                s0 += w * cact[k]; s1 += w * cact[1024 + k];
            }
            *(LAS f32x4*)(red + (kg * 2 + 0) * 128 + 4 * cq) = s0; *(LAS f32x4*)(red + (kg * 2 + 1) * 128 + 4 * cq) = s1;
            __syncthreads();
            if (tid < 256) {
                const int cc = tid & 127, bb = tid >> 7; float s = 0.f;
#pragma unroll
                for (int g = 0; g < 16; ++g) s += red[(g * 2 + bb) * 128 + cc];
                ((float*)(ws + WS_MOD))[(L * 2 + bb) * 6144 + cg0 + cc] = s + a.in[3][L * 6144 + cg0 + cc];
            }
            __syncthreads();
        }
    }
    for (int e = 0; e < 2; ++e) {
        transpose_cvt_lds(a.in[6] + (size_t)e * 1024 * 2048, 1024, 2048, (bf16_t*)(ws + WS_WABIN) + (size_t)e * 2048 * 1024, 1024, PermAbIn(), lds, BIDX, G, tid);
        transpose_cvt_lds(a.in[11] + (size_t)e * 1024 * 1024, 512, 1024, (bf16_t*)(ws + WS_WABOUT) + (size_t)e * 1024 * 1024, 1024, PermId(), lds, BIDX, G, tid);
        transpose_cvt_lds(a.in[12] + (size_t)e * 1024 * 3072, 1024, 3072, (bf16_t*)(ws + WS_WCVIN) + (size_t)e * 3072 * 1024, 1024, PermCvIn(), lds, BIDX, G, tid);
        transpose_cvt_lds(a.in[14] + (size_t)e * 1024 * 1024, 1024, 1024, (bf16_t*)(ws + WS_WCVOUT) + (size_t)e * 1024 * 1024, 1024, PermId(), lds, BIDX, G, tid);
    }
    for (int L = 0; L < 4; ++L)
        transpose_cvt_lds(a.in[15] + (size_t)L * 1024 * 2048, 1024, 2048, (bf16_t*)(ws + WS_WPQ) + (size_t)L * 2048 * 1024, 1024, PermId(), lds, BIDX, G, tid);
    for (int it = gtid; it < 2 * 512 * 256; it += gth) {
        const int n4 = it & 255, kp = (it >> 8) & 511, e = it >> 17, g = kp >> 7, i = kp & 127;
        const float* pw = a.in[9] + ((size_t)(e * 4 + g) * 128 + i) * 128;
        const float* ps = a.in[10] + e * 512 + g * 128;
        const float* wo = a.in[11] + (size_t)e * 1024 * 1024 + (size_t)(512 + g * 128) * 1024 + 4 * n4;
        f32x4 s = {0.f, 0.f, 0.f, 0.f};
#pragma unroll 8
        for (int c = 0; c < 128; ++c) s += *(const f32x4*)(wo + (size_t)c * 1024) * (pw[c] * ps[c]);
        bf16_t* dst = (bf16_t*)(ws + WS_WABOUT) + (size_t)e * 1024 * 1024 + (size_t)(4 * n4) * 1024 + 512 + kp;
        const unsigned w01 = pack2(s[0], s[1]), w23 = pack2(s[2], s[3]);
        dst[0] = (bf16_t)(w01 & 0xffffu); dst[1024] = (bf16_t)(w01 >> 16); dst[2048] = (bf16_t)(w23 & 0xffffu); dst[3072] = (bf16_t)(w23 >> 16);
    }
    cvt_u_i8(a.in[18], ws + WS_PU, (float*)(ws + WS_US), NEXP, BIDX * 8 + (tid >> 6), G * 8, tid & 63);
    for (int L = 0; L < 4; ++L) {
        cvt_elems(a.in[16] + (size_t)L * 16384, (bf16_t*)(ws + WS_KEYS) + (size_t)(L * 2 + 0) * 16384, 16384 / 8, gtid, gth);
        cvt_elems(a.in[17] + (size_t)L * 16384, (bf16_t*)(ws + WS_KEYS) + (size_t)(L * 2 + 1) * 16384, 16384 / 8, gtid, gth);
    }
}

template <bool Q8, bool XBF> DI void norm_phase(const void* __restrict__ xv, const float* __restrict__ gain, const float* __restrict__ modsh, bf16_t* __restrict__ H, unsigned char* __restrict__ H8, float* __restrict__ HS) {
    const int TIDX = mk_tid(), BIDX = mk_bid(), GDIM = mk_grid(); (void)TIDX; (void)BIDX; (void)GDIM;
    const int lane = TIDX & 63, nw = GDIM * 8;
    for (int r0 = BIDX * 8 + (TIDX >> 6); r0 < T / 2; r0 += nw) {
        f32x4 v[2][4]; float ss[2];
#pragma unroll
        for (int z = 0; z < 2; ++z) {
            ss[z] = 0.f;
#pragma unroll
            for (int j = 0; j < 4; ++j) {
                const size_t eo = (size_t)(r0 + z * (T / 2)) * 1024 + 4 * lane + 256 * j;
                if (XBF) { const u32x2 w = *(const u32x2*)((const bf16_t*)xv + eo); v[z][j] = (f32x4){bf_lo(w.x), bf_hi(w.x), bf_lo(w.y), bf_hi(w.y)}; }
                else v[z][j] = *(const f32x4*)((const float*)xv + eo);
                ss[z] += v[z][j][0] * v[z][j][0] + v[z][j][1] * v[z][j][1] + v[z][j][2] * v[z][j][2] + v[z][j][3] * v[z][j][3];
            }
        }
#pragma unroll
        for (int o = 32; o >= 1; o >>= 1) { ss[0] += __shfl_xor(ss[0], o); ss[1] += __shfl_xor(ss[1], o); }
#pragma unroll
        for (int z = 0; z < 2; ++z) {
            const int r = r0 + z * (T / 2), b = r >> 14;
            const float rstd = rsqrtf(ss[z] * (1.f / 1024.f) + EPS);
            const float* sh = modsh + b * 6144; const float* sc = sh + 1024;
            float y[4][4]; float am = 0.f;
#pragma unroll
            for (int j = 0; j < 4; ++j) {
                const int k = 4 * lane + 256 * j;
                const f32x4 g = *(const f32x4*)(gain + k), s1 = *(const f32x4*)(sc + k), s0 = *(const f32x4*)(sh + k);
#pragma unroll
                for (int i = 0; i < 4; ++i) { y[j][i] = v[z][j][i] * rstd * g[i] * (1.f + s1[i]) + s0[i]; am = fmaxf(am, fabsf(y[j][i])); }
                u32x2 w; w.x = pack2(y[j][0], y[j][1]); w.y = pack2(y[j][2], y[j][3]);
                *(u32x2*)(H + (size_t)r * 1024 + k) = w;
            }
            if (Q8) {
#pragma unroll
                for (int o = 32; o >= 1; o >>= 1) am = fmaxf(am, __shfl_xor(am, o));
                const float inv = am > 0.f ? 127.f / am : 0.f;
#pragma unroll
                for (int j = 0; j < 4; ++j) {
                    const int k = 4 * lane + 256 * j;
                    const f32x4 yy = {y[j][0], y[j][1], y[j][2], y[j][3]};
                    *(unsigned*)(H8 + ((size_t)(k >> 7) * T + r) * 128 + (k & 127)) = quant4(yy, inv);
                }
                if (lane == 0) HS[r] = am * (1.f / 127.f);
            }
        }
    }
}
#define XB_TMO      128
#define XB_XCNT(j)  (256  + 64 * (j))
#define XB_XSUB(j)  (1280 + 64 * (j))
#define XB_XGEN(j)  (2304 + 64 * (j))
#define XB_TOP      3328
#define XB_TOPGEN   3392
#define XCD_BAR_WORDS 3456
#define XB_SPIN_CAP (1u << 18)

__device__ __forceinline__ unsigned xb_ld(unsigned* p)              { return __hip_atomic_load(p, __ATOMIC_RELAXED, __HIP_MEMORY_SCOPE_AGENT); }
__device__ __forceinline__ unsigned xb_add(unsigned* p, unsigned v) { return __hip_atomic_fetch_add(p, v, __ATOMIC_RELAXED, __HIP_MEMORY_SCOPE_AGENT); }
__device__ __forceinline__ unsigned xb_xcc_id() { return (unsigned)__builtin_amdgcn_s_getreg((3 << 11) | 20) & 0xFu; }
#define XB_SPIN(cond, bar) do { unsigned _sp = 0; while (cond) { __builtin_amdgcn_s_sleep(1); \
    if ((++_sp & 255u) == 0u) { if (xb_ld(&(bar)[XB_TMO])) break; if (_sp > XB_SPIN_CAP) { atomicAdd(&(bar)[XB_TMO], 1u); break; } } } } while (0)

struct XcdBarrier {
    unsigned* bar; unsigned x;
    volatile LAS unsigned* st;
};

__device__ __forceinline__ XcdBarrier xcd_barrier_post(unsigned* bar, volatile LAS unsigned* st) {
    XcdBarrier b; b.bar = bar; b.x = xb_xcc_id(); b.st = st;
    if (threadIdx.x == 0) (void)xb_add(&bar[XB_XCNT(b.x)], 1u);
    return b;
}
__device__ __forceinline__ void xcd_barrier_complete(unsigned* bar, unsigned x, unsigned& nloc, unsigned& nx) {
    const unsigned G = gridDim.x * gridDim.y * gridDim.z;
    unsigned sum, cnt, mine, sp = 0u;
    for (;;) {
        sum = 0u; cnt = 0u; mine = 0u;
#pragma unroll
        for (unsigned j = 0; j < 16; ++j) { const unsigned c = xb_ld(&bar[XB_XCNT(j)]); sum += c; cnt += (c > 0u) ? 1u : 0u; mine = (j == x) ? c : mine; }
        if (sum == G) break;
        __builtin_amdgcn_s_sleep(1);
        if ((++sp & 255u) == 0u) { if (xb_ld(&bar[XB_TMO])) break; if (sp > XB_SPIN_CAP) { atomicAdd(&bar[XB_TMO], 1u); break; } }
    }
    nloc = mine > 0u ? mine : 1u; nx = cnt > 0u ? cnt : 1u;
}

__device__ __forceinline__ void xcd_barrier(const XcdBarrier& b) {
    asm volatile("s_waitcnt vmcnt(0)" ::: "memory");
    __syncthreads();
    if (threadIdx.x == 0) {
        unsigned* bar = b.bar;
        __builtin_amdgcn_s_waitcnt(0);
        unsigned nloc = b.st[0], nx = b.st[1];
        if (nloc == 0u) { xcd_barrier_complete(bar, b.x, nloc, nx); b.st[0] = nloc; b.st[1] = nx; }
        const unsigned old = xb_add(&bar[XB_XSUB(b.x)], 1u);
        const unsigned gen = old / nloc;
        if (old + 1u == (gen + 1u) * nloc) {
            __builtin_amdgcn_fence(__ATOMIC_RELEASE, "agent");
            asm volatile("s_waitcnt vmcnt(0)" ::: "memory");
            const unsigned og = xb_add(&bar[XB_TOP], 1u);
            const unsigned tg = og / nx;
            if (og + 1u == (tg + 1u) * nx) xb_add(&bar[XB_TOPGEN], 1u);
            else XB_SPIN(xb_ld(&bar[XB_TOPGEN]) == tg, bar);
            __builtin_amdgcn_fence(__ATOMIC_ACQUIRE, "agent");
            xb_add(&bar[XB_XGEN(b.x)], 1u);
            asm volatile("s_waitcnt vmcnt(0)" ::: "memory");
        } else {
            XB_SPIN(xb_ld(&bar[XB_XGEN(b.x)]) == gen, bar);
            __builtin_amdgcn_fence(__ATOMIC_ACQUIRE, "agent");
            asm volatile("s_waitcnt vmcnt(0)" ::: "memory");
        }
    }
    __syncthreads();
}

struct EpiQKVU {
    static constexpr bool PERM = true, AFTER_DRAIN = false;
    bf16_t* dst; const float* qgain; const float* kgain;
    DI void operator()(const f32x4 (&acc)[2][2][4][2], const Unit& u, int wr, int wc, int fr, int fq) const {
        const int region = u.pn >> 1, head = 4 * (u.pn & 1) + wc;
        const float* gain = (region == 0 ? qgain : kgain) + head * 64;
        f32x4 gv[2][2];
#pragma unroll
        for (int bj = 0; bj < 2; ++bj)
#pragma unroll
            for (int n = 0; n < 2; ++n) gv[bj][n] = (region < 2) ? *(const f32x4*)(gain + 32 * bj + 8 * fq + 4 * n) : (f32x4){1.f, 1.f, 1.f, 1.f};
#pragma unroll
        for (int ai = 0; ai < 2; ++ai)
#pragma unroll
            for (int m = 0; m < 4; ++m) {
                const int row = u.pm * 256 + ai * 128 + wr * 64 + m * 16 + fr, b = row >> 14, t = row & (SEQ - 1);
                float rs = 1.f;
                if (region < 2) {
                    float ss = 0.f;
#pragma unroll
                    for (int bj = 0; bj < 2; ++bj)
#pragma unroll
                        for (int n = 0; n < 2; ++n) { const f32x4 x = acc[ai][bj][m][n]; ss += (x[0] * x[0] + x[1] * x[1]) + (x[2] * x[2] + x[3] * x[3]); }
                    ss += __shfl_xor(ss, 16); ss += __shfl_xor(ss, 32);
                    rs = rsqrtf(ss * (1.f / 64.f) + EPS);
                }
                bf16_t* p = dst + (size_t)region * ((size_t)T * 512) + ((size_t)(b * 8 + head) * SEQ + t) * 64 + 8 * fq;
#pragma unroll
                for (int bj = 0; bj < 2; ++bj) {
                    const f32x4 v0 = acc[ai][bj][m][0] * gv[bj][0] * rs, v1 = acc[ai][bj][m][1] * gv[bj][1] * rs;
                    u32x4 w; w.x = pack2(v0[0], v0[1]); w.y = pack2(v0[2], v0[3]); w.z = pack2(v1[0], v1[1]); w.w = pack2(v1[2], v1[3]);
                    *(u32x4*)(p + 32 * bj) = w;
                }
            }
    }
};
struct EpiResid {
    static constexpr bool PERM = true, AFTER_DRAIN = false;
    const float* base32; const bf16_t* base16; bf16_t* out; const float* gate;
    DI void operator()(const f32x4 (&acc)[2][2][4][2], const Unit& u, int wr, int wc, int fr, int fq) const {
        const int b = (u.pm * 256) >> 14, col0 = u.pn * 256 + wc * 32 + 8 * fq;
        f32x4 gv[2][2];
#pragma unroll
        for (int bj = 0; bj < 2; ++bj)
#pragma unroll
            for (int n = 0; n < 2; ++n) gv[bj][n] = *(const f32x4*)(gate + b * 6144 + col0 + bj * 128 + 4 * n);
#pragma unroll
        for (int ai = 0; ai < 2; ++ai)
#pragma unroll
            for (int m = 0; m < 4; ++m) {
                const size_t off = (size_t)(u.pm * 256 + ai * 128 + wr * 64 + m * 16 + fr) * 1024 + col0;
#pragma unroll
                for (int bj = 0; bj < 2; ++bj) {
                    f32x4 x0, x1;
                    if (base32) { x0 = *(const f32x4*)(base32 + off + bj * 128); x1 = *(const f32x4*)(base32 + off + bj * 128 + 4); }
                    else { const u32x4 w = *(const u32x4*)(base16 + off + bj * 128); x0 = (f32x4){bf_lo(w.x), bf_hi(w.x), bf_lo(w.y), bf_hi(w.y)}; x1 = (f32x4){bf_lo(w.z), bf_hi(w.z), bf_lo(w.w), bf_hi(w.w)}; }
                    const f32x4 v0 = x0 + gv[bj][0] * acc[ai][bj][m][0], v1 = x1 + gv[bj][1] * acc[ai][bj][m][1];
                    u32x4 o; o.x = pack2(v0[0], v0[1]); o.y = pack2(v0[2], v0[3]); o.z = pack2(v1[0], v1[1]); o.w = pack2(v1[2], v1[3]);
                    *(u32x4*)(out + off + bj * 128) = o;
                }
            }
    }
};
struct EpiConvIn {
    static constexpr bool PERM = true, AFTER_DRAIN = false;
    bf16_t* U; bf16_t* GB;
    DI void operator()(const f32x4 (&acc)[2][2][4][2], const Unit& u, int wr, int wc, int fr, int fq) const {
#pragma unroll
        for (int ai = 0; ai < 2; ++ai)
#pragma unroll
            for (int m = 0; m < 4; ++m) {
                const size_t row = (size_t)(u.pm * 256 + ai * 128 + wr * 64 + m * 16 + fr);
                if (u.pn < 8) {
                    const f32x4 v0 = acc[ai][0][m][0] * acc[ai][1][m][0], v1 = acc[ai][0][m][1] * acc[ai][1][m][1];
                    u32x4 w; w.x = pack2(v0[0], v0[1]); w.y = pack2(v0[2], v0[3]); w.z = pack2(v1[0], v1[1]); w.w = pack2(v1[2], v1[3]);
                    *(u32x4*)(U + row * 1024 + 128 * u.pn + 32 * wc + 8 * fq) = w;
                } else {
#pragma unroll
                    for (int bj = 0; bj < 2; ++bj) {
                        const f32x4 v0 = acc[ai][bj][m][0], v1 = acc[ai][bj][m][1];
                        u32x4 w; w.x = pack2(v0[0], v0[1]); w.y = pack2(v0[2], v0[3]); w.z = pack2(v1[0], v1[1]); w.w = pack2(v1[2], v1[3]);
                        *(u32x4*)(GB + row * 1024 + 256 * (u.pn - 8) + 128 * bj + 32 * wc + 8 * fq) = w;
                    }
                }
            }
    }
};
struct EpiPlain {
    static constexpr bool PERM = true, AFTER_DRAIN = false;
    bf16_t* O; int ldc;
    DI void operator()(const f32x4 (&acc)[2][2][4][2], const Unit& u, int wr, int wc, int fr, int fq) const {
#pragma unroll
        for (int ai = 0; ai < 2; ++ai)
#pragma unroll
            for (int m = 0; m < 4; ++m) {
                bf16_t* p = O + (size_t)(u.pm * 256 + ai * 128 + wr * 64 + m * 16 + fr) * ldc + u.pn * 256 + 32 * wc + 8 * fq;
#pragma unroll
                for (int bj = 0; bj < 2; ++bj) {
                    const f32x4 v0 = acc[ai][bj][m][0], v1 = acc[ai][bj][m][1];
                    u32x4 w; w.x = pack2(v0[0], v0[1]); w.y = pack2(v0[2], v0[3]); w.z = pack2(v1[0], v1[1]); w.w = pack2(v1[2], v1[3]);
                    *(u32x4*)(p + 128 * bj) = w;
                }
            }
    }
};
template <class Epi> DI void run_gemm(LAS unsigned char* lds, const bf16_t* A, const bf16_t* Bt, int N, const Epi& E) {
    const int TIDX = mk_tid(), BIDX = mk_bid(), GDIM = mk_grid(); (void)TIDX; (void)BIDX; (void)GDIM;
    pg8::Gemm g{A, Bt, T, N, 1024}; pg8::StaticOrder S; S.init(T, N, GDIM, (int)BIDX);
    pg8::gemm_phase<Epi, pg8::StaticOrder, true, true>(lds, g, S, E);
}

typedef short s16x4 __attribute__((ext_vector_type(4)));
DI void attn_phase(const bf16_t* __restrict__ Q, const bf16_t* __restrict__ K, const bf16_t* __restrict__ V, bf16_t* __restrict__ ycat, LAS unsigned char* lds) {
    const int TIDX = mk_tid(), BIDX = mk_bid(), GDIM = mk_grid(); (void)TIDX; (void)BIDX; (void)GDIM;
    const int lane = TIDX & 63, wave = __builtin_amdgcn_readfirstlane(TIDX >> 6), lr = lane & 31, h = lane >> 5;
    LAS unsigned char* vl0 = lds + wave * 9216;
    const unsigned trb0 = (unsigned)(size_t)vl0 + (unsigned)((4 * h + ((lane >> 2) & 3)) * 144 + (16 * ((lane >> 4) & 1) + 4 * (lane & 3)) * 2);
    const float NEG = -__builtin_inff();
    const float sc = 0.125f * 1.4426950408889634f;
    const int xj = BIDX & 7, nteam = (GDIM - xj + 7) >> 3, lw = (BIDX >> 3) * 8 + wave, nlw = nteam * 8;
    for (int lp = lw; lp < 512; lp += nlw) {
        const int bh = 2 * xj + (lp >> 8), rest = lp & 255, blk = rest >> 2, r0 = 2 * (rest & 3);
        const size_t base = (size_t)bh * SEQ * 64;
        bf16x8 qf[2][4]; f32x16 o0[2], o1[2]; float mrun[2], lrun[2]; int tq[2];
#pragma unroll
        for (int z = 0; z < 2; ++z) {
            tq[z] = r0 + z + 8 * (blk * 32 + lr);
#pragma unroll
            for (int kk = 0; kk < 4; ++kk) qf[z][kk] = *(const bf16x8*)(Q + base + (size_t)tq[z] * 64 + 16 * kk + 8 * h);
#pragma unroll
            for (int i = 0; i < 16; ++i) { o0[z][i] = 0.f; o1[z][i] = 0.f; }
            mrun[z] = NEG; lrun[z] = 0.f;
        }
#pragma unroll
        for (int br = 0; br < 4; ++br) {
            const int d = br == 0 ? 1 : (br == 1 ? 4 : 16), nkb = br == 0 ? 12 : (br == 1 ? 6 : 5);
            int rho[2], kstart[2], uq[2], lo[2]; unsigned dead;
            dead = (br >= 2 && (lr & 1) != br - 2) ? 0x40000000u : 0u;
#pragma unroll
            for (int z = 0; z < 2; ++z) {
                const int r = r0 + z;
                int u0;
                if (br == 0) { rho[z] = 0; u0 = r + 256 * blk; uq[z] = u0 + 8 * lr; }
                else if (br == 1) { rho[z] = r & 3; u0 = (r >> 2) + 64 * blk; uq[z] = u0 + 2 * lr; }
                else { rho[z] = r + 8 * (br - 2); u0 = 16 * blk; uq[z] = u0 + (lr >> 1); }
                kstart[z] = u0 - 128; lo[z] = uq[z] < 128 ? -uq[z] : -128;
            }
            for (int kb = 0; kb < nkb; ++kb) {
                bf16x8 kf[2][4]; u32x4 vv[2][4];
#pragma unroll
                for (int z = 0; z < 2; ++z) {
                    int kc = kstart[z] + 32 * kb + lr; kc = kc < 0 ? 0 : kc;
                    int pos = rho[z] + d * kc; pos = pos > SEQ - 1 ? SEQ - 1 : pos;
                    const bf16_t* kp = K + base + (size_t)pos * 64; const bf16_t* vp = V + base + (size_t)pos * 64;
#pragma unroll
                    for (int kk = 0; kk < 4; ++kk) kf[z][kk] = *(const bf16x8*)(kp + 16 * kk + 8 * h);
#pragma unroll
                    for (int i = 0; i < 4; ++i) vv[z][i] = *(const u32x4*)(vp + 32 * h + 8 * i);
                }
                asm volatile("" ::: "memory");
#pragma unroll
                for (int z = 0; z < 2; ++z)
#pragma unroll
                    for (int i = 0; i < 4; ++i) *(LAS u32x4*)(vl0 + z * 4608 + lr * 144 + h * 64 + i * 16) = vv[z][i];
                asm volatile("" ::: "memory");
                f32x16 st[2];
#pragma unroll
                for (int z = 0; z < 2; ++z) {
#pragma unroll
                    for (int i = 0; i < 16; ++i) st[z][i] = 0.f;
#pragma unroll
                    for (int kk = 0; kk < 4; ++kk) st[z] = MFMA32(kf[z][kk], qf[z][kk], st[z]);
                }
                float bm[2]; bool raise[2];
#pragma unroll
                for (int z = 0; z < 2; ++z) {
                    const unsigned xb = dead ? 0x40000000u : (unsigned)(kstart[z] + 32 * kb - uq[z] - lo[z] + 4 * h), wl = (unsigned)(-lo[z]);
                    float m = NEG;
#pragma unroll
                    for (int i = 0; i < 16; ++i) {
                        const bool valid = (xb + (unsigned)((i & 3) + 8 * (i >> 2))) <= wl;
                        st[z][i] = valid ? st[z][i] : NEG; m = fmaxf(m, st[z][i]);
                    }
                    bm[z] = m;
                }
#pragma unroll
                for (int z = 0; z < 2; ++z) { bm[z] = fmaxf(bm[z], __shfl_xor(bm[z], 32)) * sc; raise[z] = bm[z] > mrun[z] + 8.f; }
                if (__builtin_amdgcn_ballot_w64(raise[0] || raise[1]) != 0ull) {
#pragma unroll
                    for (int z = 0; z < 2; ++z) {
                        const float mnew = raise[z] ? bm[z] : mrun[z];
                        const float alpha = raise[z] ? __builtin_amdgcn_exp2f(mrun[z] - mnew) : 1.f;
                        lrun[z] *= alpha; mrun[z] = mnew;
#pragma unroll
                        for (int i = 0; i < 16; ++i) { o0[z][i] *= alpha; o1[z][i] *= alpha; }
                    }
                }
                bf16x8 pf0[2], pf1[2];
#pragma unroll
                for (int z = 0; z < 2; ++z) {
                    const float nm = (mrun[z] == NEG) ? 0.f : -mrun[z];
                    float ps = 0.f; float p[16];
#pragma unroll
                    for (int i = 0; i < 16; ++i) { p[i] = __builtin_amdgcn_exp2f(__builtin_fmaf(st[z][i], sc, nm)); ps += p[i]; }
                    lrun[z] += ps;
                    u32x4 pw0, pw1;
                    pw0.x = pack2(p[0], p[1]); pw0.y = pack2(p[2], p[3]); pw0.z = pack2(p[4], p[5]); pw0.w = pack2(p[6], p[7]);
                    pw1.x = pack2(p[8], p[9]); pw1.y = pack2(p[10], p[11]); pw1.z = pack2(p[12], p[13]); pw1.w = pack2(p[14], p[15]);
                    pf0[z] = __builtin_bit_cast(bf16x8, pw0); pf1[z] = __builtin_bit_cast(bf16x8, pw1);
                }
#pragma unroll
                for (int z = 0; z < 2; ++z) {
                    s16x4 t00, t01, t10, t11, t20, t21, t30, t31;
                    asm volatile("ds_read_b64_tr_b16 %0, %8 offset:0\n\tds_read_b64_tr_b16 %1, %8 offset:1152\n\t"
                                 "ds_read_b64_tr_b16 %2, %8 offset:64\n\tds_read_b64_tr_b16 %3, %8 offset:1216\n\t"
                                 "ds_read_b64_tr_b16 %4, %8 offset:2304\n\tds_read_b64_tr_b16 %5, %8 offset:3456\n\t"
                                 "ds_read_b64_tr_b16 %6, %8 offset:2368\n\tds_read_b64_tr_b16 %7, %8 offset:3520\n\t"
                                 "s_waitcnt lgkmcnt(0)"
                                 : "=&v"(t00), "=&v"(t01), "=&v"(t10), "=&v"(t11), "=&v"(t20), "=&v"(t21), "=&v"(t30), "=&v"(t31) : "v"(trb0 + z * 4608) : "memory");
                    const bf16x8 vf00 = __builtin_shufflevector(t00, t01, 0, 1, 2, 3, 4, 5, 6, 7);
                    const bf16x8 vf01 = __builtin_shufflevector(t10, t11, 0, 1, 2, 3, 4, 5, 6, 7);
                    const bf16x8 vf10 = __builtin_shufflevector(t20, t21, 0, 1, 2, 3, 4, 5, 6, 7);
                    const bf16x8 vf11 = __builtin_shufflevector(t30, t31, 0, 1, 2, 3, 4, 5, 6, 7);
                    o0[z] = MFMA32(vf00, pf0[z], o0[z]); o1[z] = MFMA32(vf01, pf0[z], o1[z]);
                    o0[z] = MFMA32(vf10, pf1[z], o0[z]); o1[z] = MFMA32(vf11, pf1[z], o1[z]);
                }
                asm volatile("" ::: "memory");
            }
        }
        const int b = bh >> 3, head = bh & 7;
#pragma unroll
        for (int z = 0; z < 2; ++z) {
            const float ltot = lrun[z] + __shfl_xor(lrun[z], 32), inv = 1.f / ltot;
            bf16_t* op = ycat + ((size_t)b * SEQ + tq[z]) * 1024 + head * 64;
#pragma unroll
            for (int g = 0; g < 4; ++g) {
                u32x2 w0, w1;
                w0.x = pack2(o0[z][4 * g] * inv, o0[z][4 * g + 1] * inv); w0.y = pack2(o0[z][4 * g + 2] * inv, o0[z][4 * g + 3] * inv);
                w1.x = pack2(o1[z][4 * g] * inv, o1[z][4 * g + 1] * inv); w1.y = pack2(o1[z][4 * g + 2] * inv, o1[z][4 * g + 3] * inv);
                *(u32x2*)(op + 8 * g + 4 * h) = w0; *(u32x2*)(op + 32 + 8 * g + 4 * h) = w1;
            }
        }
    }
}
DI void pool_phase(const bf16_t* __restrict__ Uh, bf16_t* __restrict__ ycat) {
    const int TIDX = mk_tid(), BIDX = mk_bid(), GDIM = mk_grid(); (void)TIDX; (void)BIDX; (void)GDIM;
    const int gth = GDIM * 512;
    for (int it = BIDX * 512 + TIDX; it < T * 8 * 8; it += gth) {
        const int ck = it & 7, t = (it >> 3) & (SEQ - 1), bh = it >> 17, h8 = bh & 7, b = bh >> 3;
        const int w = 2 << (h8 >> 1), cnt = (t + 1 < w) ? t + 1 : w;
        const bf16_t* p = Uh + ((size_t)bh * SEQ + t) * 64 + 8 * ck;
        float s[8], u0[8];
#pragma unroll
        for (int i = 0; i < 8; ++i) s[i] = 0.f;
        for (int j = 0; j < cnt; ++j) {
            const u32x4 v = *(const u32x4*)(p - (size_t)j * 64);
            const float f[8] = {bf_lo(v.x), bf_hi(v.x), bf_lo(v.y), bf_hi(v.y), bf_lo(v.z), bf_hi(v.z), bf_lo(v.w), bf_hi(v.w)};
#pragma unroll
            for (int i = 0; i < 8; ++i) { s[i] += f[i]; if (j == 0) u0[i] = f[i]; }
        }
        const float ic = 1.f / (float)cnt;
        u32x4 o; o.x = pack2(s[0] * ic - u0[0], s[1] * ic - u0[1]); o.y = pack2(s[2] * ic - u0[2], s[3] * ic - u0[3]); o.z = pack2(s[4] * ic - u0[4], s[5] * ic - u0[5]); o.w = pack2(s[6] * ic - u0[6], s[7] * ic - u0[7]);
        *(u32x4*)(ycat + ((size_t)b * SEQ + t) * 1024 + 512 + 64 * h8 + 8 * ck) = o;
    }
}
DI void conv_phase(const bf16_t* __restrict__ U, const bf16_t* __restrict__ GB, const float* __restrict__ cw, bf16_t* __restrict__ Z) {
    const int TIDX = mk_tid(), BIDX = mk_bid(), GDIM = mk_grid(); (void)TIDX; (void)BIDX; (void)GDIM;
    const int gth = GDIM * 512;
    for (int it = BIDX * 512 + TIDX; it < T * 128; it += gth) {
        const int ck = it & 127, r = it >> 7, t = r & (SEQ - 1);
        const size_t off = (size_t)r * 1024 + 8 * ck;
        const u32x4 z4 = {0u, 0u, 0u, 0u};
        const u32x4 a0 = *(const u32x4*)(U + off), a1 = t >= 1 ? *(const u32x4*)(U + off - 1024) : z4, a2 = t >= 2 ? *(const u32x4*)(U + off - 2048) : z4, gb = *(const u32x4*)(GB + off);
        const float f0[8] = {bf_lo(a0.x), bf_hi(a0.x), bf_lo(a0.y), bf_hi(a0.y), bf_lo(a0.z), bf_hi(a0.z), bf_lo(a0.w), bf_hi(a0.w)};
        const float f1[8] = {bf_lo(a1.x), bf_hi(a1.x), bf_lo(a1.y), bf_hi(a1.y), bf_lo(a1.z), bf_hi(a1.z), bf_lo(a1.w), bf_hi(a1.w)};
        const float f2[8] = {bf_lo(a2.x), bf_hi(a2.x), bf_lo(a2.y), bf_hi(a2.y), bf_lo(a2.z), bf_hi(a2.z), bf_lo(a2.w), bf_hi(a2.w)};
        const float fg[8] = {bf_lo(gb.x), bf_hi(gb.x), bf_lo(gb.y), bf_hi(gb.y), bf_lo(gb.z), bf_hi(gb.z), bf_lo(gb.w), bf_hi(gb.w)};
        float y[8];
#pragma unroll
        for (int i = 0; i < 8; ++i) { const int c = 8 * ck + i; y[i] = fg[i] * (cw[c] * f0[i] + cw[1024 + c] * f1[i] + cw[2048 + c] * f2[i]); }
        u32x4 o; o.x = pack2(y[0], y[1]); o.y = pack2(y[2], y[3]); o.z = pack2(y[4], y[5]); o.w = pack2(y[6], y[7]);
        *(u32x4*)(Z + off) = o;
    }
}
DI void cmpx(float& a, float& b) { const float mx = fmaxf(a, b), mn = fminf(a, b); a = mx; b = mn; }
DI void cmpx_asc(float& a, float& b) { const float mx = fmaxf(a, b), mn = fminf(a, b); a = mn; b = mx; }
template <int K, int J> struct BitonicStage {
    template <int N> static DI void run(float (&v)[N], int base) {
#pragma unroll
        for (int i = 0; i < 16; ++i) { const int l = i ^ J; if (l > i) { if ((i & K) == 0) cmpx(v[base + i], v[base + l]); else cmpx_asc(v[base + i], v[base + l]); } }
    }
};
template <int N> DI void sort16_desc(float (&v)[N], int base) {
    cmpx(v[base + 0], v[base + 1]); cmpx(v[base + 2], v[base + 3]); cmpx(v[base + 0], v[base + 2]); cmpx(v[base + 1], v[base + 3]); cmpx(v[base + 1], v[base + 2]);
    cmpx(v[base + 4], v[base + 5]); cmpx(v[base + 6], v[base + 7]); cmpx(v[base + 4], v[base + 6]); cmpx(v[base + 5], v[base + 7]); cmpx(v[base + 5], v[base + 6]);
    cmpx(v[base + 0], v[base + 4]); cmpx(v[base + 2], v[base + 6]); cmpx(v[base + 2], v[base + 4]); cmpx(v[base + 1], v[base + 5]); cmpx(v[base + 3], v[base + 7]);
    cmpx(v[base + 3], v[base + 5]); cmpx(v[base + 1], v[base + 2]); cmpx(v[base + 3], v[base + 4]); cmpx(v[base + 5], v[base + 6]); cmpx(v[base + 8], v[base + 9]);
    cmpx(v[base + 10], v[base + 11]); cmpx(v[base + 8], v[base + 10]); cmpx(v[base + 9], v[base + 11]); cmpx(v[base + 9], v[base + 10]); cmpx(v[base + 12], v[base + 13]);
    cmpx(v[base + 14], v[base + 15]); cmpx(v[base + 12], v[base + 14]); cmpx(v[base + 13], v[base + 15]); cmpx(v[base + 13], v[base + 14]); cmpx(v[base + 8], v[base + 12]);
    cmpx(v[base + 10], v[base + 14]); cmpx(v[base + 10], v[base + 12]); cmpx(v[base + 9], v[base + 13]); cmpx(v[base + 11], v[base + 15]); cmpx(v[base + 11], v[base + 13]);
    cmpx(v[base + 9], v[base + 10]); cmpx(v[base + 11], v[base + 12]); cmpx(v[base + 13], v[base + 14]); cmpx(v[base + 0], v[base + 8]); cmpx(v[base + 4], v[base + 12]);
    cmpx(v[base + 4], v[base + 8]); cmpx(v[base + 2], v[base + 10]); cmpx(v[base + 6], v[base + 14]); cmpx(v[base + 6], v[base + 10]); cmpx(v[base + 2], v[base + 4]);
    cmpx(v[base + 6], v[base + 8]); cmpx(v[base + 10], v[base + 12]); cmpx(v[base + 1], v[base + 9]); cmpx(v[base + 5], v[base + 13]); cmpx(v[base + 5], v[base + 9]);
    cmpx(v[base + 3], v[base + 11]); cmpx(v[base + 7], v[base + 15]); cmpx(v[base + 7], v[base + 11]); cmpx(v[base + 3], v[base + 5]); cmpx(v[base + 7], v[base + 9]);
    cmpx(v[base + 11], v[base + 13]); cmpx(v[base + 1], v[base + 2]); cmpx(v[base + 3], v[base + 4]); cmpx(v[base + 5], v[base + 6]); cmpx(v[base + 7], v[base + 8]);
    cmpx(v[base + 9], v[base + 10]); cmpx(v[base + 11], v[base + 12]); cmpx(v[base + 13], v[base + 14]);
}
DI void merge16_desc(float (&L)[16]) {
#pragma unroll
    for (int st = 8; st >= 1; st >>= 1)
#pragma unroll
        for (int i = 0; i < 16; ++i) if ((i & st) == 0) cmpx(L[i], L[i + st]);
}
DI void top16_of_64(float (&s)[64], float (&top)[16]) {
    sort16_desc(s, 0); sort16_desc(s, 16); sort16_desc(s, 32); sort16_desc(s, 48);
    float A[16], B[16];
#pragma unroll
    for (int i = 0; i < 16; ++i) { A[i] = fmaxf(s[i], s[31 - i]); B[i] = fmaxf(s[32 + i], s[63 - i]); }
    merge16_desc(A); merge16_desc(B);
#pragma unroll
    for (int i = 0; i < 16; ++i) top[i] = fmaxf(A[i], B[15 - i]);
    merge16_desc(top);
}
DI void top16_of_cands(float (&c)[64], float (&top)[16]) {
    sort16_desc(c, 16); sort16_desc(c, 32);
    cmpx(c[48], c[49]);
    float A[16], B[16];
#pragma unroll
    for (int i = 0; i < 16; ++i) { A[i] = fmaxf(c[i], c[31 - i]); B[i] = c[32 + i]; }
    B[15] = fmaxf(B[15], c[48]); B[14] = fmaxf(B[14], c[49]);
    merge16_desc(A); merge16_desc(B);
#pragma unroll
    for (int i = 0; i < 16; ++i) top[i] = fmaxf(A[i], B[15 - i]);
    merge16_desc(top);
}
struct Stair { int a[50], b[50]; constexpr Stair() : a{}, b{} { int c = 0; for (int x = 0; x < 16; ++x) for (int y = 0; y < 16; ++y) if ((x + 1) * (y + 1) <= 16) { a[c] = x; b[c] = y; ++c; } } };
DI void route_qload(bf16x8 (&qf)[8], const bf16_t* __restrict__ qp) {
#pragma unroll
    for (int kk = 0; kk < 8; ++kk) qf[kk] = *(const bf16x8*)(qp + 16 * kk);
}
DI void route_scores(const bf16x8 (&qf)[8], const LAS unsigned char* kl, int lr, int h, float (&s)[64]) {
#pragma unroll
    for (int mb = 0; mb < 4; ++mb) {
        f32x16 c;
#pragma unroll
        for (int i = 0; i < 16; ++i) c[i] = 0.f;
        const LAS unsigned char* kp = kl + (32 * mb + lr) * 272 + 16 * h;
#pragma unroll
        for (int kk = 0; kk < 8; ++kk) c = MFMA32(*(const LAS bf16x8*)(kp + 32 * kk), qf[kk], c);
#pragma unroll
        for (int i = 0; i < 16; ++i) { const unsigned key = 32 * mb + (i & 3) + 8 * (i >> 2) + 4 * h; s[mb * 16 + i] = __uint_as_float((__float_as_uint(c[i]) & ~127u) | key); }
    }
}
DI void route_top(float (&s)[64], float (&out)[16]) {
    float top[16];
    top16_of_64(s, top);
    float L[16];
#pragma unroll
    for (int i = 0; i < 16; ++i) L[i] = __shfl_xor(top[15 - i], 32);
#pragma unroll
    for (int i = 0; i < 16; ++i) L[i] = fmaxf(top[i], L[i]);
    merge16_desc(L);
#pragma unroll
    for (int i = 0; i < 16; ++i) out[i] = L[i];
}
DI void route_phase(const bf16_t* __restrict__ PQ, const bf16_t* __restrict__ KEYS, int* __restrict__ ridx, float* __restrict__ rgate, LAS unsigned char* lds) {
    const int TIDX = mk_tid(), BIDX = mk_bid(), GDIM = mk_grid(); (void)TIDX; (void)BIDX; (void)GDIM;
    const int lane = TIDX & 63, wave = TIDX >> 6, lr = lane & 31, h = lane >> 5, nw = GDIM * 8;
    const float NEG = -__builtin_inff();
    for (int it = TIDX; it < 2 * 128 * 16; it += 512) { const int row = it >> 4, ck = it & 15; *(LAS u32x4*)(lds + row * 272 + ck * 16) = *(const u32x4*)(KEYS + (size_t)row * 128 + ck * 8); }
    if (TIDX < 64) { int c = TIDX, x = 0; for (; x < 16; ++x) { const int cnt = 16 / (x + 1); if (c < cnt) break; c -= cnt; } ((LAS unsigned char*)(lds + 69632))[TIDX] = (unsigned char)((x & 15) | ((c & 15) << 4)); }
    __syncthreads();
    bf16x8 qA[8], qB[8];
    { const int u0 = BIDX * 8 + wave, p0 = (u0 < T * 8 / 32 ? u0 : 0) * 32 + lr; const bf16_t* q0 = PQ + (size_t)(p0 >> 3) * 2048 + (p0 & 7) * 256 + 8 * h; route_qload(qA, q0); }
    for (int unit = BIDX * 8 + wave; unit < T * 8 / 32; unit += nw) {
        const int pair = unit * 32 + lr, tok = pair >> 3, head = pair & 7;
        float vs[2][16];
        const int nunit = (unit + nw < T * 8 / 32) ? unit + nw : unit;
        const int npair = nunit * 32 + lr;
        const bf16_t* qn = PQ + (size_t)(npair >> 3) * 2048 + (npair & 7) * 256 + 8 * h;
        route_qload(qB, PQ + (size_t)tok * 2048 + head * 256 + 8 * h + 128);
        {
            float s[64];
            route_scores(qA, lds, lr, h, s);
            route_qload(qA, qn);
            route_top(s, vs[0]);
        }
        __builtin_amdgcn_sched_barrier(0);
        {
            float s[64];
            route_scores(qB, lds + 128 * 272, lr, h, s);
            route_top(s, vs[1]);
        }
        __builtin_amdgcn_sched_barrier(0);
        float cand[64];
#pragma unroll
        for (int cid = 0; cid < 64; ++cid) {
            constexpr Stair ST{};
            if (cid < 50) { const float sum = vs[0][ST.a[cid]] + vs[1][ST.b[cid]]; cand[cid] = __uint_as_float((__float_as_uint(sum) & ~63u) | (unsigned)cid); }
            else cand[cid] = NEG;
        }
        float tv[16]; int te[16];
        top16_of_cands(cand, tv);
        LAS unsigned* mine = (LAS unsigned*)(lds + 69760 + wave * 4352) + lane * 17;
#pragma unroll
        for (int q = 0; q < 8; ++q) {
            mine[q] = (__float_as_uint(vs[0][2 * q]) & 127u) | ((__float_as_uint(vs[0][2 * q + 1]) & 127u) << 16);
            mine[8 + q] = (__float_as_uint(vs[1][2 * q]) & 127u) | ((__float_as_uint(vs[1][2 * q + 1]) & 127u) << 16);
        }
        asm volatile("s_waitcnt lgkmcnt(0)" ::: "memory");
        const LAS unsigned char* ctab = (const LAS unsigned char*)(lds + 69632);
        const LAS unsigned short* mine16 = (const LAS unsigned short*)mine;
#pragma unroll
        for (int it = 0; it < 16; ++it) {
            const unsigned ab = ctab[__float_as_uint(tv[it]) & 63u];
            te[it] = (int)((((unsigned)mine16[ab & 15u] << 7) | (unsigned)mine16[16 + (ab >> 4)]) << 7);
        }
        asm volatile("" ::: "memory");
        const float m0 = tv[0]; float den = 0.f; float ex[16];
#pragma unroll
        for (int i = 0; i < 16; ++i) { ex[i] = __expf(tv[i] - m0); den += ex[i]; }
        const float inv = 1.f / den;
        {
            int* ip = ridx + (size_t)tok * 128 + head * 16; float* gp = rgate + (size_t)tok * 128 + head * 16;
#pragma unroll
            for (int q = 0; q < 4; ++q) {
                *(int4*)(ip + 4 * q) = make_int4(te[4 * q], te[4 * q + 1], te[4 * q + 2], te[4 * q + 3]);
                *(float4*)(gp + 4 * q) = make_float4(ex[4 * q] * inv, ex[4 * q + 1] * inv, ex[4 * q + 2] * inv, ex[4 * q + 3] * inv);
            }
        }
    }
}
DI float gelu_exact(float x) { return 0.5f * x * (1.f + erff(x * 0.70710678118654752f)); }
typedef const unsigned char* cu8p;
struct Team { int j, wit, nwt; };
DI Team team_of(int bidx, int wave, int G) { Team tm; tm.j = bidx & 7; const int nteam = (G - tm.j + 7) >> 3; tm.wit = (bidx >> 3) * 8 + wave; tm.nwt = nteam * 8; return tm; }
DI void idx_load(int (&e)[16], const int* __restrict__ ridx, int t, int g) {
    const int4* ip = (const int4*)(ridx + (size_t)t * 128 + 16 * g);
#pragma unroll
    for (int q = 0; q < 4; ++q) { const int4 v = ip[q]; e[4 * q] = v.x; e[4 * q + 1] = v.y; e[4 * q + 2] = v.z; e[4 * q + 3] = v.w; }
}
DI void rows_load(u32x4 (&uu)[16], cu8p tabj, const int (&e)[16], unsigned moff) {
#pragma unroll
    for (int i = 0; i < 16; ++i) uu[i] = *(const u32x4*)(tabj + ((unsigned)e[i] | moff));
}
DI void pu_compute(const u32x4 (&uu)[16], const u32x4 hq, int m, int& keep0, int& keep1) {
#pragma unroll
    for (int i = 0; i < 16; ++i) {
        int d = __builtin_amdgcn_sdot4((int)uu[i].x, (int)hq.x, 0, false);
        d = __builtin_amdgcn_sdot4((int)uu[i].y, (int)hq.y, d, false); d = __builtin_amdgcn_sdot4((int)uu[i].z, (int)hq.z, d, false); d = __builtin_amdgcn_sdot4((int)uu[i].w, (int)hq.w, d, false);
        d += __builtin_amdgcn_update_dpp(0, d, 0xB1, 0xf, 0xf, true);
        d += __builtin_amdgcn_update_dpp(0, d, 0x4E, 0xf, 0xf, true);
        d += __builtin_amdgcn_update_dpp(0, d, 0x141, 0xf, 0xf, true);
        if (i < 8) keep0 = (m == i) ? d : keep0; else keep1 = (m == i - 8) ? d : keep1;
    }
}
DI void peer_u_phase(cu8p __restrict__ H8, cu8p __restrict__ PU8, const int* __restrict__ ridx, int* __restrict__ P,
                     const float* __restrict__ tu, const float* __restrict__ tv, unsigned char* __restrict__ dU, unsigned char* __restrict__ dV, float* __restrict__ us, int L) {
    const int TIDX = mk_tid(), BIDX = mk_bid(), GDIM = mk_grid(); (void)TIDX; (void)BIDX; (void)GDIM;
    const int lane = TIDX & 63, g = lane >> 3, m = lane & 7;
    const Team tm = team_of(BIDX, TIDX >> 6, GDIM);
    cu8p tabj = PU8 + (size_t)tm.j * NEXP * 128;
    const unsigned moff = 16u * m;
    cu8p hb = H8 + (size_t)tm.j * T * 128 + 16 * m;
    int* Pj = P + (size_t)tm.j * T * 128 + 16 * g + m;
    u32x4 ua[16], ub[16]; int ea[16], eb[16];
    int t = tm.wit;
    const int n1 = tm.nwt;
#define TCL(x) ((x) < T ? (x) : T - 1)
    idx_load(ea, ridx, TCL(t), g);
    idx_load(eb, ridx, TCL(t + n1), g);
    u32x4 hqa = *(const u32x4*)(hb + (size_t)TCL(t) * 128);
    rows_load(ua, tabj, ea, moff);
    const int njr = (L < 3) ? 2 * NEXP : NEXP, gw = BIDX * 8 + (TIDX >> 6), gnw = GDIM * 8;
    int jr = gw; f32x4 ja[4];
    for (; t < T; t += 2 * n1) {
        const int t1 = t + n1, t2 = t + 2 * n1, t3 = t + 3 * n1;
        rows_load(ub, tabj, eb, moff);
        const u32x4 hqb = *(const u32x4*)(hb + (size_t)TCL(t1) * 128);
        idx_load(ea, ridx, TCL(t2), g);
        const bool j0 = jr < njr; if (j0) cj_issue(ja, tu, tv, L, jr, lane);
        __builtin_amdgcn_sched_barrier(0);
        int k0 = 0, k1 = 0;
        pu_compute(ua, hqa, m, k0, k1);
        Pj[(size_t)t * 128] = k0; Pj[(size_t)t * 128 + 8] = k1;
        if (j0) { cj_finish(ja, dU, dV, us, L, jr, lane); jr += gnw; }
        __builtin_amdgcn_sched_barrier(0);
        rows_load(ua, tabj, ea, moff);
        hqa = *(const u32x4*)(hb + (size_t)TCL(t2) * 128);
        idx_load(eb, ridx, TCL(t3), g);
        const bool j1 = jr < njr; if (j1) cj_issue(ja, tu, tv, L, jr, lane);
        __builtin_amdgcn_sched_barrier(0);
        k0 = 0; k1 = 0;
        pu_compute(ub, hqb, m, k0, k1);
        if (t1 < T) { Pj[(size_t)t1 * 128] = k0; Pj[(size_t)t1 * 128 + 8] = k1; }
        if (j1) { cj_finish(ja, dU, dV, us, L, jr, lane); jr += gnw; }
        __builtin_amdgcn_sched_barrier(0);
    }
    for (; jr < njr; jr += gnw) { cj_issue(ja, tu, tv, L, jr, lane); cj_finish(ja, dU, dV, us, L, jr, lane); }
}
DI void peer_r_phase(const int* __restrict__ P, const int* __restrict__ ridx, const float* __restrict__ rgate, const float* __restrict__ HS, const float* __restrict__ US, float* __restrict__ W) {
    const int TIDX = mk_tid(), BIDX = mk_bid(), GDIM = mk_grid(); (void)TIDX; (void)BIDX; (void)GDIM;
    const int gth = GDIM * 512;
    for (int it = BIDX * 512 + TIDX; it < T * 128; it += gth) {
        int s = 0;
#pragma unroll
        for (int j = 0; j < 8; ++j) s += P[(size_t)j * T * 128 + it];
        const float pre = (float)s * HS[it >> 7] * US[ridx[it] >> 7];
        W[it] = rgate[it] * gelu_exact(pre) * 0.125f;
    }
}
typedef _Float16 h2_t __attribute__((ext_vector_type(2)));
DI void w_load(float (&w)[16], const float* __restrict__ W, int t, int g) {
    const float4* wp = (const float4*)(W + (size_t)t * 128 + 16 * g);
#pragma unroll
    for (int q = 0; q < 4; ++q) { const float4 v = wp[q]; w[4 * q] = v.x; w[4 * q + 1] = v.y; w[4 * q + 2] = v.z; w[4 * q + 3] = v.w; }
}
DI void pv_compute(const u32x4 (&vv)[16], const float (&w)[16], int lane, const bf16_t* xr, bf16_t* xw, float* xf, const float* gg, bool store) {
    h2_t oh[8];
#pragma unroll
    for (int q = 0; q < 8; ++q) oh[q] = (h2_t){(_Float16)0.f, (_Float16)0.f};
#pragma unroll
    for (int i = 0; i < 16; ++i) {
        const _Float16 wh = (_Float16)w[i];
        const h2_t w2 = {wh, wh};
#pragma unroll
        for (int q = 0; q < 4; ++q) {
            oh[2 * q] += w2 * __builtin_amdgcn_cvt_scalef32_pk_f16_fp8(vv[i][q], 1.0f, false);
            oh[2 * q + 1] += w2 * __builtin_amdgcn_cvt_scalef32_pk_f16_fp8(vv[i][q], 1.0f, true);
        }
    }
    f32x2_t o2[8];
#pragma unroll
    for (int q = 0; q < 8; ++q) o2[q] = (f32x2_t){(float)oh[q][0], (float)oh[q][1]};
    f32x2_t q4[4], r2[2], fin;
#pragma unroll
    for (int i = 0; i < 4; ++i)
#pragma unroll
        for (int c = 0; c < 2; ++c) {
            const auto sw = __builtin_amdgcn_permlane32_swap(__float_as_uint(o2[i][c]), __float_as_uint(o2[4 + i][c]), false, false);
            q4[i][c] = __uint_as_float(sw[0]) + __uint_as_float(sw[1]);
        }
#pragma unroll
    for (int i = 0; i < 2; ++i)
#pragma unroll
        for (int c = 0; c < 2; ++c) {
            const auto sw = __builtin_amdgcn_permlane16_swap(__float_as_uint(q4[i][c]), __float_as_uint(q4[2 + i][c]), false, false);
            r2[i][c] = __uint_as_float(sw[0]) + __uint_as_float(sw[1]);
        }
    { const bool b3 = lane & 8; const f32x2_t keep = b3 ? r2[1] : r2[0], send = b3 ? r2[0] : r2[1];
      fin[0] = keep[0] + __int_as_float(__builtin_amdgcn_update_dpp(0, __float_as_int(send[0]), 0x128, 0xf, 0xf, true));
      fin[1] = keep[1] + __int_as_float(__builtin_amdgcn_update_dpp(0, __float_as_int(send[1]), 0x128, 0xf, 0xf, true)); }
    if (store) {
        const unsigned xw2 = *(const unsigned*)xr; const f32x2_t xv = {bf_lo(xw2), bf_hi(xw2)}, gv = *(const f32x2_t*)gg, r = xv + gv * fin;
        if (xw) *(unsigned*)xw = pack2(r[0], r[1]); else *(f32x2_t*)xf = r;
    }
}
DI void peer_v_phase(cu8p __restrict__ PV8, const int* __restrict__ ridx, const float* __restrict__ W, const bf16_t* xin, bf16_t* xout, float* fout, const float* __restrict__ g2) {
    const int TIDX = mk_tid(), BIDX = mk_bid(), GDIM = mk_grid(); (void)TIDX; (void)BIDX; (void)GDIM;
    const int lane = TIDX & 63, g = lane >> 3, m = lane & 7;
    const Team tm = team_of(BIDX, TIDX >> 6, GDIM);
    cu8p tabj = PV8 + (size_t)tm.j * NEXP * 128;
    const unsigned moff = 16u * m;
    const int col = 128 * tm.j + 16 * m + 2 * g;
    u32x4 va[16], vb[16]; int ea[16], eb[16]; float wa[16], wb[16];
    int t = tm.wit;
    const int n1 = tm.nwt;
    idx_load(ea, ridx, TCL(t), g);
    idx_load(eb, ridx, TCL(t + n1), g);
    rows_load(va, tabj, ea, moff); w_load(wa, W, TCL(t), g);
    for (; t < T; t += 2 * n1) {
        const int t1 = t + n1, t1c = TCL(t1), t2 = t + 2 * n1, t3 = t + 3 * n1;
        rows_load(vb, tabj, eb, moff); w_load(wb, W, t1c, g);
        idx_load(ea, ridx, TCL(t2), g);
        __builtin_amdgcn_sched_barrier(0);
        pv_compute(va, wa, lane, xin + (size_t)t * 1024 + col, xout ? xout + (size_t)t * 1024 + col : nullptr, fout + (size_t)t * 1024 + col, g2 + (t >> 14) * 6144 + col, true);
        __builtin_amdgcn_sched_barrier(0);
        rows_load(va, tabj, ea, moff); w_load(wa, W, TCL(t2), g);
        idx_load(eb, ridx, TCL(t3), g);
        __builtin_amdgcn_sched_barrier(0);
        pv_compute(vb, wb, lane, xin + (size_t)t1c * 1024 + col, xout ? xout + (size_t)t1c * 1024 + col : nullptr, fout + (size_t)t1c * 1024 + col, g2 + (t1c >> 14) * 6144 + col, t1 < T);
        __builtin_amdgcn_sched_barrier(0);
    }
}

DI void seam_barrier(unsigned char* ws, LAS unsigned char* lds) {
    XcdBarrier b; b.bar = (unsigned*)(ws + WS_BAR); b.x = xb_xcc_id(); b.st = (volatile LAS unsigned*)(lds + 131072);
    xcd_barrier(b);
}
__global__ void __launch_bounds__(512, 2) fwd(Args a) {
    extern __shared__ __attribute__((aligned(16))) unsigned char lds_raw[];
    LAS unsigned char* lds = (LAS unsigned char*)lds_raw;
    cg::grid_group grid = cg::this_grid();
    const int TIDX0 = mk_tid(), BIDX0 = mk_bid();
    unsigned char* ws = a.ws;
    const float* MOD = (const float*)(ws + WS_MOD);
    bf16_t* Hb = (bf16_t*)(ws + WS_H); bf16_t* BIG = (bf16_t*)(ws + WS_BIG); bf16_t* YC = (bf16_t*)(ws + WS_YCAT);
    int* RI = (int*)(ws + WS_RIDX); float* RG = (float*)(ws + WS_RGATE);
#ifdef PROBE_SYNCS
    for (int i = 0; i < 40; ++i) grid.sync();
#endif
    if (BIDX0 == 0) for (int i = TIDX0; i < XCD_BAR_WORDS; i += 512) ((unsigned*)(ws + WS_BAR))[i] = 0u;
    if (TIDX0 < 4) ((LAS unsigned*)(lds + 131072))[TIDX0] = 0u;
    p0_prologue(a, lds);
    grid.sync();
    (void)xcd_barrier_post((unsigned*)(ws + WS_BAR), (volatile LAS unsigned*)(lds + 131072));
#ifdef PROBE_DUP_P0
    p0_prologue(a, lds);
    seam_barrier(ws, lds);
#endif
    for (int L = 0; L < 4; ++L) {
        bf16_t* XB = (bf16_t*)(ws + WS_XB);
        const float* modL = MOD + (size_t)L * 2 * 6144;
        if (L == 0) norm_phase<false, false>(a.in[0], a.in[4] + L * 1024, modL, Hb, nullptr, nullptr); else norm_phase<false, true>(XB, a.in[4] + L * 1024, modL, Hb, nullptr, nullptr);
        seam_barrier(ws, lds);
        if ((L & 1) == 0) {
            const int e = L >> 1;
            { EpiQKVU E{BIG, a.in[7] + e * 512, a.in[8] + e * 512}; run_gemm(lds, Hb, (const bf16_t*)(ws + WS_WABIN) + (size_t)e * 2048 * 1024, 2048, E); }
            seam_barrier(ws, lds);
            attn_phase(BIG, BIG + (size_t)T * 512, BIG + (size_t)2 * T * 512, YC, lds);
#ifdef PROBE_DUP_ATTN
            seam_barrier(ws, lds);
            attn_phase(BIG, BIG + (size_t)T * 512, BIG + (size_t)2 * T * 512, (bf16_t*)(ws + WS_END), lds);
#endif
            pool_phase(BIG + (size_t)3 * T * 512, YC);
            seam_barrier(ws, lds);
            { EpiResid E{L == 0 ? a.in[0] : nullptr, XB, XB, modL + 2048}; run_gemm(lds, YC, (const bf16_t*)(ws + WS_WABOUT) + (size_t)e * 1024 * 1024, 1024, E); }
        } else {
            const int o = L >> 1;
            { EpiConvIn E{BIG, BIG + (size_t)T * 1024}; run_gemm(lds, Hb, (const bf16_t*)(ws + WS_WCVIN) + (size_t)o * 3072 * 1024, 3072, E); }
            seam_barrier(ws, lds);
            conv_phase(BIG, BIG + (size_t)T * 1024, a.in[13] + (size_t)o * 3072, YC);
            seam_barrier(ws, lds);
            { EpiResid E{L == 0 ? a.in[0] : nullptr, XB, XB, modL + 2048}; run_gemm(lds, YC, (const bf16_t*)(ws + WS_WCVOUT) + (size_t)o * 1024 * 1024, 1024, E); }
        }
        seam_barrier(ws, lds);
        norm_phase<true, true>(XB, a.in[5] + L * 1024, modL + 3072, Hb, ws + WS_H8, (float*)(ws + WS_HS));
        seam_barrier(ws, lds);
        { EpiPlain E{BIG, 2048}; run_gemm(lds, Hb, (const bf16_t*)(ws + WS_WPQ) + (size_t)L * 2048 * 1024, 2048, E); }
        seam_barrier(ws, lds);
        route_phase(BIG, (const bf16_t*)(ws + WS_KEYS) + (size_t)L * 2 * 16384, RI, RG, lds);
        seam_barrier(ws, lds);
        peer_u_phase(ws + WS_H8, (cu8p)(ws + WS_PU) + (size_t)L * 8 * NEXP * 128, RI, (int*)(ws + WS_P), a.in[18], a.in[19], ws + WS_PU, ws + WS_PV, (float*)(ws + WS_US), L);
        seam_barrier(ws, lds);
#ifdef PROBE_DUP_U
        peer_u_phase(ws + WS_H8, (cu8p)(ws + WS_PU) + (size_t)L * 8 * NEXP * 128, RI, (int*)(ws + WS_P), a.in[18], a.in[19], ws + WS_PU, ws + WS_PV, (float*)(ws + WS_US), L);
        seam_barrier(ws, lds);
#endif
        peer_r_phase((const int*)(ws + WS_P), RI, RG, (const float*)(ws + WS_HS), (const float*)(ws + WS_US) + (size_t)L * NEXP, (float*)(ws + WS_W));
        seam_barrier(ws, lds);
#ifdef PROBE_DUP_V
        peer_v_phase((cu8p)(ws + WS_PV) + (size_t)L * 8 * NEXP * 128, RI, (const float*)(ws + WS_W), XB, (bf16_t*)(ws + WS_END2), a.out, modL + 5120);
        seam_barrier(ws, lds);
#endif
        peer_v_phase((cu8p)(ws + WS_PV) + (size_t)L * 8 * NEXP * 128, RI, (const float*)(ws + WS_W), XB, L == 3 ? nullptr : XB, a.out, modL + 5120);
        seam_barrier(ws, lds);
#ifdef PROBE_DUP_ROUTE
        route_phase(BIG, (const bf16_t*)(ws + WS_KEYS) + (size_t)L * 2 * 16384, (int*)(ws + WS_END), (float*)(ws + WS_END + 16 * MiB), lds);
        seam_barrier(ws, lds);
#endif
    }
}

extern "C" void kernel_launch(void* const* d_in, const int* in_sizes, int n_in, void* d_out, int out_size, void* d_ws, size_t ws_size, hipStream_t stream) {
    static int grid = 0;
    if (grid == 0) {
        int dev = 0, cus = 0, per_cu = 0;
        if (n_in != 20 || out_size != T * Dm || ws_size < WS_END2 + 160 * MiB) { fprintf(stderr, "kernel_launch: unexpected shapes (n_in %d out %d ws %zu)\n", n_in, out_size, ws_size); grid = -1; return; }
        if (hipGetDevice(&dev) != hipSuccess || hipDeviceGetAttribute(&cus, hipDeviceAttributeMultiprocessorCount, dev) != hipSuccess) { grid = -1; return; }
        if (hipFuncSetAttribute((const void*)fwd, hipFuncAttributeMaxDynamicSharedMemorySize, LDS_BYTES) != hipSuccess) { fprintf(stderr, "hipFuncSetAttribute failed\n"); grid = -1; return; }
        if (hipOccupancyMaxActiveBlocksPerMultiprocessor(&per_cu, (const void*)fwd, 512, LDS_BYTES) != hipSuccess || per_cu < 1) { fprintf(stderr, "occupancy query: %d blocks/CU\n", per_cu); grid = -1; return; }
        grid = cus - cus % 8;
        if (grid < 8) { fprintf(stderr, "kernel_launch: needs at least 8 CUs\n"); grid = -1; return; }
    }
    if (grid < 0) return;
    Args a{};
    for (int i = 0; i < 20; ++i) a.in[i] = (const float*)d_in[i];
    a.out = (float*)d_out; a.ws = (unsigned char*)d_ws; a.ph_lo = 0; a.ph_hi = 0;
    void* args[] = {&a};
    hipError_t e = hipLaunchCooperativeKernel((const void*)fwd, dim3(grid), dim3(512), args, LDS_BYTES, stream);
    if (e != hipSuccess) fprintf(stderr, "cooperative launch failed: %s (grid %d)\n", hipGetErrorString(e), grid);
}
```

```cpp
#include <hip/hip_runtime.h>
#include <hip/hip_cooperative_groups.h>
#include <cstdio>
namespace cg = cooperative_groups;
__device__ __forceinline__ int mk_tid() { int t = threadIdx.x; asm volatile("" : "+v"(t)); return t; }
__device__ __forceinline__ int mk_bid() { int t = blockIdx.x; asm volatile("" : "+s"(t)); return t; }
__device__ __forceinline__ int mk_grid() { int t = gridDim.x; asm volatile("" : "+s"(t)); return t; }
namespace pg8 {
#define PG8_LAS __attribute__((address_space(3)))
typedef unsigned short bf16_t;
typedef short bf16x8 __attribute__((ext_vector_type(8)));
typedef float f32x4 __attribute__((ext_vector_type(4)));
typedef unsigned u32x4 __attribute__((ext_vector_type(4)));
constexpr int BM = 256, BK = 64, HALF = 128, HTB = HALF * BK * 2  , STAGE_BYTES = 8 * HTB, NXCD = 8, WGM = 8;

__host__ __device__ __forceinline__ int lds_byte(int r, int c) { const int st = (r >> 4) * 2 + (c >> 5), rr = r & 15, cc = c & 31, ob = rr * 64 + cc * 2; return st * 1024 + (ob ^ (((ob >> 9) & 1) << 5)); }
__host__ __device__ __forceinline__ void stage_rc(int b, int& R, int& C) { const int st = b / 1024, sb = b % 1024, swz = sb ^ (((sb >> 9) & 1) << 5); R = (st >> 1) * 16 + swz / 64; C = (st & 1) * 32 + (swz % 64) / 2; }
__host__ __device__ __forceinline__ int perm32(int rho) { const int n = rho >> 4, i = rho & 15; return 8 * (i >> 2) + 4 * n + (i & 3); }

struct Unit { int pm, pn; };
struct Gemm { const bf16_t* A; const bf16_t* Bt; int M, N, K; };

struct StaticOrder {
    int nM, nN, nwg, G, c;
    __host__ __device__ void init(int M, int N, int G_, int c_) { nM = M / BM; nN = N / BM; nwg = nM * nN; G = G_; c = c_; }
    __host__ __device__ bool next(int i, Unit& u) const {
        const long L = (long)i * G + c; if (L >= nwg) return false;
        int wgid = (int)L; { const int q = nwg / NXCD, r = nwg % NXCD, xcd = wgid % NXCD, off = wgid / NXCD; wgid = (xcd < r ? xcd * (q + 1) : r * (q + 1) + (xcd - r) * q) + off; }
        const int nig = WGM * nN, gid = wgid / nig, fm = gid * WGM, gsz = (nM - fm) < WGM ? (nM - fm) : WGM;
        u.pm = fm + ((wgid % nig) % gsz); u.pn = (wgid % nig) / gsz; return true;
    }
    __device__ __forceinline__ void a_ready(const Unit&) const {}
    __device__ __forceinline__ void done(const Unit&) const {}
};


template <class Epi, class Sched, bool ALIGN_EPI = false, bool SP2 = false>
__device__ __forceinline__ void gemm_phase(PG8_LAS unsigned char* lds, const Gemm g, const Sched& S, const Epi& E) {
    const int tid = mk_tid(), wid = __builtin_amdgcn_readfirstlane(tid >> 6), lane = tid & 63, wr = wid >> 2, wc = wid & 3, fr = lane & 15, fq = lane >> 4;
    const int K = g.K, nt = K / BK;
    unsigned voffA[2], voffB[2];
#pragma unroll
    for (int i = 0; i < 2; ++i) { int R, C; stage_rc(tid * 16 + i * 8192, R, C); const int Rb = Epi::PERM ? ((R & ~31) + perm32(R & 31)) : R;
        voffA[i] = (unsigned)(R * K + C) * 2u; voffB[i] = (unsigned)(Rb * K + C) * 2u; }
    const size_t kstep = (size_t)(BK * 2);
    const size_t hstep = (size_t)HALF * K * 2;
    const size_t tstep = 2 * hstep;
    const unsigned ldsw = (unsigned)wid * 1024u;
    const int aoff = lds_byte(wr * 64 + fr, fq * 8), boff = lds_byte(wc * 32 + fr, fq * 8);
#define PG8_SA(b, h) (((b) * 2 + (h)) * HTB)
#define PG8_SB(b, h) ((4 + (b) * 2 + (h)) * HTB)
#define PG8_STAGE(bufoff, gbase, voff) do { _Pragma("unroll") for (int _i = 0; _i < 2; ++_i) \
        __builtin_amdgcn_global_load_lds((const unsigned*)((const char*)(gbase) + (voff)[_i]), (PG8_LAS unsigned*)(lds + (bufoff) + ldsw + _i * 8192), 16, 0, 0); } while (0)
#define PG8_LDA(dst, b, h) do { _Pragma("unroll") for (int m = 0; m < 4; ++m) _Pragma("unroll") for (int k = 0; k < 2; ++k) dst[m][k] = *(const PG8_LAS bf16x8*)(lds + PG8_SA(b, h) + aoff + m * 2048 + k * 1024); } while (0)
#define PG8_LDB(dst, b, h) do { _Pragma("unroll") for (int n = 0; n < 2; ++n) _Pragma("unroll") for (int k = 0; k < 2; ++k) dst[n][k] = *(const PG8_LAS bf16x8*)(lds + PG8_SB(b, h) + boff + n * 2048 + k * 1024); } while (0)
#define PG8_MMA(ai, bj, At, Bt) do { __builtin_amdgcn_s_setprio(1); _Pragma("unroll") for (int m = 0; m < 4; ++m) _Pragma("unroll") for (int n = 0; n < 2; ++n) _Pragma("unroll") for (int k = 0; k < 2; ++k) \
        acc[ai][bj][m][n] = __builtin_amdgcn_mfma_f32_16x16x32_bf16(Bt[n][k], At[m][k], acc[ai][bj][m][n], 0, 0, 0); __builtin_amdgcn_s_setprio(0); } while (0)
#define PG8_WAIT_V(n) asm volatile("s_waitcnt vmcnt(" #n ")" ::: "memory")
#define PG8_WAIT_L(n) asm volatile("s_waitcnt lgkmcnt(" #n ")" ::: "memory")
#define PG8_BAR __builtin_amdgcn_s_barrier()
#define PG8_SCHED __builtin_amdgcn_sched_barrier(0)
    Unit cur, nxt; int ui = 0;
    if (!S.next(0, cur)) return;
    f32x4 acc[2][2][4][2];
#pragma unroll
    for (int a = 0; a < 2; ++a)
#pragma unroll
        for (int b = 0; b < 2; ++b)
#pragma unroll
            for (int m = 0; m < 4; ++m)
#pragma unroll
                for (int n = 0; n < 2; ++n) acc[a][b][m][n] = (f32x4){0.f, 0.f, 0.f, 0.f};
    bf16x8 At[4][2], B0[2][2], B1[2][2];
    const char* cA = (const char*)g.A + (size_t)cur.pm * tstep; const char* cB = (const char*)g.Bt + (size_t)cur.pn * tstep;
    S.a_ready(cur);
    if constexpr (SP2) {
        PG8_STAGE(PG8_SB(0, 0), cB, voffB); PG8_STAGE(PG8_SB(0, 1), cB + hstep, voffB); PG8_STAGE(PG8_SA(0, 0), cA, voffA); PG8_STAGE(PG8_SA(0, 1), cA + hstep, voffA);
        if (wr == 1) PG8_BAR;
        PG8_WAIT_V(2); PG8_BAR;
        PG8_STAGE(PG8_SB(1, 0), cB + kstep, voffB); PG8_STAGE(PG8_SA(1, 0), cA + kstep, voffA); PG8_STAGE(PG8_SB(1, 1), cB + hstep + kstep, voffB);
        PG8_WAIT_V(6); PG8_BAR;
    } else {
        PG8_STAGE(PG8_SB(0, 0), cB, voffB); PG8_STAGE(PG8_SA(0, 0), cA, voffA); PG8_STAGE(PG8_SB(0, 1), cB + hstep, voffB); PG8_STAGE(PG8_SA(0, 1), cA + hstep, voffA);
        if (wr == 1) PG8_BAR;
        PG8_WAIT_V(4); PG8_BAR;
        PG8_STAGE(PG8_SB(1, 0), cB + kstep, voffB); PG8_STAGE(PG8_SA(1, 0), cA + kstep, voffA); PG8_STAGE(PG8_SB(1, 1), cB + hstep + kstep, voffB);
        PG8_WAIT_V(6); PG8_BAR;
    }
    for (;;) {
        const bool has_next = S.next(ui + 1, nxt);
        const char* nA = has_next ? (const char*)g.A + (size_t)nxt.pm * tstep : cA; const char* nB = has_next ? (const char*)g.Bt + (size_t)nxt.pn * tstep : cB;
        for (int t = 0; t < nt; t += 2) {
            const bool last = (t == nt - 2);
            const char* a1 = cA + (size_t)(t + 1) * kstep;
            const char* a2 = last ? nA : cA + (size_t)(t + 2) * kstep; const char* b2 = last ? nB : cB + (size_t)(t + 2) * kstep;
            const char* a3 = a2 + kstep; const char* b3 = b2 + kstep;
            if (last && has_next) S.a_ready(nxt);
            if constexpr (SP2) {
            PG8_LDB(B0, 0, 0); PG8_LDB(B1, 0, 1); PG8_SCHED; PG8_LDA(At, 0, 0); PG8_STAGE(PG8_SA(1, 1), a1 + hstep, voffA);
            PG8_WAIT_V(8); PG8_WAIT_L(0); PG8_BAR; PG8_MMA(0, 0, At, B0); PG8_MMA(0, 1, At, B1); PG8_BAR; PG8_SCHED;
            PG8_LDA(At, 0, 1); PG8_STAGE(PG8_SB(0, 0), b2, voffB); PG8_STAGE(PG8_SB(0, 1), b2 + hstep, voffB); PG8_STAGE(PG8_SA(0, 0), a2, voffA);
            PG8_WAIT_V(8); PG8_WAIT_L(0); PG8_BAR; PG8_MMA(1, 0, At, B0); PG8_MMA(1, 1, At, B1); PG8_BAR; PG8_SCHED;
            PG8_LDB(B0, 1, 0); PG8_LDB(B1, 1, 1); PG8_SCHED; PG8_LDA(At, 1, 0); PG8_STAGE(PG8_SA(0, 1), a2 + hstep, voffA);
            PG8_WAIT_V(8); PG8_WAIT_L(0); PG8_BAR; PG8_MMA(0, 0, At, B0); PG8_MMA(0, 1, At, B1); PG8_BAR; PG8_SCHED;
            PG8_LDA(At, 1, 1); PG8_STAGE(PG8_SB(1, 0), b3, voffB); PG8_STAGE(PG8_SB(1, 1), b3 + hstep, voffB); PG8_STAGE(PG8_SA(1, 0), a3, voffA);
            PG8_WAIT_V(8); PG8_WAIT_L(0); PG8_BAR; PG8_MMA(1, 0, At, B0); PG8_MMA(1, 1, At, B1); PG8_BAR; PG8_SCHED;
            } else {
            PG8_LDB(B0, 0, 0); PG8_SCHED; PG8_LDA(At, 0, 0); PG8_STAGE(PG8_SA(1, 1), a1 + hstep, voffA);
            PG8_WAIT_L(8); PG8_BAR; PG8_WAIT_L(0); PG8_MMA(0, 0, At, B0); PG8_BAR; PG8_SCHED;
            PG8_LDB(B1, 0, 1); PG8_STAGE(PG8_SB(0, 0), b2, voffB);
            PG8_BAR; PG8_WAIT_L(0); PG8_MMA(0, 1, At, B1); PG8_BAR;
            PG8_LDA(At, 0, 1); PG8_STAGE(PG8_SA(0, 0), a2, voffA);
            PG8_BAR; PG8_WAIT_L(0); PG8_MMA(1, 0, At, B0); PG8_BAR; PG8_SCHED;
            PG8_STAGE(PG8_SB(0, 1), b2 + hstep, voffB);
            PG8_WAIT_V(6); PG8_BAR; PG8_MMA(1, 1, At, B1); PG8_BAR;
            PG8_LDB(B0, 1, 0); PG8_SCHED; PG8_LDA(At, 1, 0); PG8_STAGE(PG8_SA(0, 1), a2 + hstep, voffA);
            PG8_WAIT_L(8); PG8_BAR; PG8_WAIT_L(0); PG8_MMA(0, 0, At, B0); PG8_BAR; PG8_SCHED;
            PG8_LDB(B1, 1, 1); PG8_STAGE(PG8_SB(1, 0), b3, voffB);
            PG8_BAR; PG8_WAIT_L(0); PG8_MMA(0, 1, At, B1); PG8_BAR;
            PG8_LDA(At, 1, 1); PG8_STAGE(PG8_SA(1, 0), a3, voffA);
            PG8_BAR; PG8_WAIT_L(0); PG8_MMA(1, 0, At, B0); PG8_BAR; PG8_SCHED;
            PG8_STAGE(PG8_SB(1, 1), b3 + hstep, voffB);
            PG8_WAIT_V(6); PG8_BAR; PG8_MMA(1, 1, At, B1); PG8_BAR;
            }
        }
        if constexpr (ALIGN_EPI) { if (wr == 0) PG8_BAR; }
        if constexpr (!Epi::AFTER_DRAIN) { E(acc, cur, wr, wc, fr, fq); S.done(cur); }
        if (!has_next) break;
#pragma unroll
        for (int a = 0; a < 2; ++a)
#pragma unroll
            for (int b = 0; b < 2; ++b)
#pragma unroll
                for (int m = 0; m < 4; ++m)
#pragma unroll
                    for (int n = 0; n < 2; ++n) acc[a][b][m][n] = (f32x4){0.f, 0.f, 0.f, 0.f};
        cur = nxt; cA = nA; cB = nB; ++ui;
        if constexpr (ALIGN_EPI) { if (wr == 1) PG8_BAR; }
    }
    PG8_WAIT_V(0);
    if constexpr (!ALIGN_EPI) { if (wr == 0) PG8_BAR; }
    PG8_BAR;
    if constexpr (Epi::AFTER_DRAIN) { E.fused(acc, cur, wr, wc, fr, fq, lds, wid, lane); S.done(cur); }
#undef PG8_SA
#undef PG8_SB
#undef PG8_STAGE
#undef PG8_LDA
#undef PG8_LDB
#undef PG8_MMA
#undef PG8_WAIT_V
#undef PG8_WAIT_L
#undef PG8_BAR
#undef PG8_SCHED
}
}
using pg8::bf16_t; using pg8::bf16x8; using pg8::f32x4; using pg8::u32x4; using pg8::Unit;
#define LAS PG8_LAS
#define DI __device__ __forceinline__
typedef __bf16 bf16x2_t __attribute__((ext_vector_type(2)));
typedef float f32x2_t __attribute__((ext_vector_type(2)));
typedef float f32x16 __attribute__((ext_vector_type(16)));
typedef unsigned u32x2 __attribute__((ext_vector_type(2)));
#define MFMA32(a, b, c) __builtin_amdgcn_mfma_f32_32x32x16_bf16((a), (b), (c), 0, 0, 0)

constexpr int Dm = 1024, NBATCH = 2, SEQ = 16384, T = NBATCH * SEQ, NEXP = 16384;
constexpr float EPS = 1e-6f;
constexpr size_t MiB = 1u << 20;
constexpr size_t WS_MOD = 0, WS_KEYS = 256 * 1024, WS_WABIN = 1 * MiB, WS_WABOUT = 9 * MiB, WS_WCVIN = 13 * MiB, WS_WCVOUT = 25 * MiB, WS_WPQ = 29 * MiB,
                 WS_PU = 45 * MiB, WS_PV = 173 * MiB, WS_H = 301 * MiB, WS_BIG = 365 * MiB, WS_YCAT = 493 * MiB, WS_RIDX = 557 * MiB, WS_RGATE = 573 * MiB, WS_END = 589 * MiB,
                 WS_H8 = 589 * MiB, WS_P = 621 * MiB, WS_W = 749 * MiB, WS_HS = 765 * MiB, WS_US = 766 * MiB, WS_BAR = 767 * MiB, WS_XB = 768 * MiB, WS_END2 = 832 * MiB;
constexpr int LDS_BYTES = 131072 + 16;

DI unsigned pack2(float lo, float hi) { f32x2_t v = {lo, hi}; bf16x2_t b = __builtin_convertvector(v, bf16x2_t); return __builtin_bit_cast(unsigned, b); }
DI float bf_lo(unsigned w) { return __uint_as_float(w << 16); }
DI float bf_hi(unsigned w) { return __uint_as_float(w & 0xffff0000u); }
DI float dot2bf(unsigned a, unsigned b, float c) { return __builtin_amdgcn_fdot2_f32_bf16(__builtin_bit_cast(bf16x2_t, a), __builtin_bit_cast(bf16x2_t, b), c, false); }
DI float rdlane(float v, int l) { return __int_as_float(__builtin_amdgcn_readlane(__float_as_int(v), l)); }

struct Args { const float* in[20]; float* out; unsigned char* ws; int ph_lo, ph_hi; };

template <class Perm> DI void transpose_cvt_lds(const float* __restrict__ W, int K, int N, bf16_t* __restrict__ Bt, int ldb, Perm perm, LAS unsigned char* lds, int bidx, int G, int tid) {
    LAS unsigned short* Tl = (LAS unsigned short*)lds;
    const int nnt = N / 64, ntiles = (K / 64) * nnt;
    for (int tile = bidx; tile < ntiles; tile += G) {
        const int kt = tile / nnt, nt = tile % nnt;
        {
            const int kr = tid >> 3, nq = tid & 7, src = perm(64 * nt + 8 * nq);
            const float* p = W + (size_t)(64 * kt + kr) * N + src;
            const f32x4 v0 = *(const f32x4*)p, v1 = *(const f32x4*)(p + 4);
            const unsigned w0 = pack2(v0[0], v0[1]), w1 = pack2(v0[2], v0[3]), w2 = pack2(v1[0], v1[1]), w3 = pack2(v1[2], v1[3]);
            LAS unsigned short* q = Tl + (8 * nq) * 66 + kr;
            q[0] = (unsigned short)(w0 & 0xffffu); q[66] = (unsigned short)(w0 >> 16); q[132] = (unsigned short)(w1 & 0xffffu); q[198] = (unsigned short)(w1 >> 16);
            q[264] = (unsigned short)(w2 & 0xffffu); q[330] = (unsigned short)(w2 >> 16); q[396] = (unsigned short)(w3 & 0xffffu); q[462] = (unsigned short)(w3 >> 16);
        }
        __syncthreads();
        {
            const int nr = tid >> 3, kc = tid & 7;
            const LAS unsigned* r = (const LAS unsigned*)(Tl + nr * 66 + 8 * kc);
            u32x4 w; w.x = r[0]; w.y = r[1]; w.z = r[2]; w.w = r[3];
            *(u32x4*)(Bt + (size_t)(64 * nt + nr) * ldb + 64 * kt + 8 * kc) = w;
        }
        __syncthreads();
    }
}
struct PermId { DI int operator()(int n) const { return n; } };
struct PermAbIn { DI int operator()(int n) const { const int pn = n >> 8, ct = n & 255, bj = ct >> 7, wc = (ct >> 5) & 3, j = ct & 31; return 256 * pn + 64 * wc + 32 * bj + j; } };
struct PermCvIn { DI int operator()(int n) const { const int pn = n >> 8, ct = n & 255; if (pn < 8) return (ct < 128) ? 128 * pn + ct : 2048 + 128 * pn + (ct - 128); return 1024 + (n - 2048); } };

DI void cvt_elems(const float* __restrict__ src, bf16_t* __restrict__ dst, size_t n8, size_t gtid, size_t gthreads) {
    for (size_t it = gtid; it < n8; it += gthreads) {
        const f32x4 a = *(const f32x4*)(src + it * 8), b = *(const f32x4*)(src + it * 8 + 4);
        u32x4 w; w.x = pack2(a[0], a[1]); w.y = pack2(a[2], a[3]); w.z = pack2(b[0], b[1]); w.w = pack2(b[2], b[3]);
        *(u32x4*)(dst + it * 8) = w;
    }
}

DI unsigned quant4(f32x4 a, float inv) {
    unsigned w = 0;
    w = __builtin_amdgcn_cvt_pk_u8_f32(a[0] * inv + 128.f, 0, w); w = __builtin_amdgcn_cvt_pk_u8_f32(a[1] * inv + 128.f, 1, w);
    w = __builtin_amdgcn_cvt_pk_u8_f32(a[2] * inv + 128.f, 2, w); w = __builtin_amdgcn_cvt_pk_u8_f32(a[3] * inv + 128.f, 3, w);
    return w ^ 0x80808080u;
}
DI void cvt_u_i8(const float* __restrict__ src, unsigned char* __restrict__ dst, float* __restrict__ us, int nrows, int gwave, int nwaves, int lane) {
    for (int row = gwave; row < nrows; row += nwaves) {
        f32x4 a[4]; float am = 0.f;
#pragma unroll
        for (int q = 0; q < 4; ++q) { a[q] = *(const f32x4*)(src + (size_t)row * 1024 + 16 * lane + 4 * q); am = fmaxf(am, fmaxf(fmaxf(fabsf(a[q][0]), fabsf(a[q][1])), fmaxf(fabsf(a[q][2]), fabsf(a[q][3])))); }
#pragma unroll
        for (int o = 32; o >= 1; o >>= 1) am = fmaxf(am, __shfl_xor(am, o));
        const float inv = am > 0.f ? 127.f / am : 0.f;
        u32x4 w;
#pragma unroll
        for (int q = 0; q < 4; ++q) w[q] = quant4(a[q], inv);
        const size_t L = row >> 14, e = row & (NEXP - 1);
        *(u32x4*)(dst + ((L * 8 + (lane >> 3)) * NEXP + e) * 128 + 16 * (lane & 7)) = w;
        if (lane == 0) us[row] = am * (1.f / 127.f);
    }
}
DI void cj_issue(f32x4 (&a)[4], const float* __restrict__ pu, const float* __restrict__ pv, int L, int jr, int lane) {
    const float* src = (jr < NEXP) ? pv + ((size_t)L * NEXP + jr) * 1024 : pu + ((size_t)(L + 1) * NEXP + (jr - NEXP)) * 1024;
#pragma unroll
    for (int q = 0; q < 4; ++q) a[q] = *(const f32x4*)(src + 16 * lane + 4 * q);
}
DI void cj_finish(const f32x4 (&a)[4], unsigned char* __restrict__ dU, unsigned char* __restrict__ dV, float* __restrict__ us, int L, int jr, int lane) {
    u32x4 w;
    if (jr < NEXP) {
#pragma unroll
        for (int q = 0; q < 4; ++q) {
            const f32x4 b = a[q] * 8.f;
            int pk = __builtin_amdgcn_cvt_pk_fp8_f32(b[0], b[1], 0, false);
            pk = __builtin_amdgcn_cvt_pk_fp8_f32(b[2], b[3], pk, true);
            w[q] = (unsigned)pk;
        }
        *(u32x4*)(dV + (((size_t)L * 8 + (lane >> 3)) * NEXP + jr) * 128 + 16 * (lane & 7)) = w;
    } else {
        const int e = jr - NEXP; float am = 0.f;
#pragma unroll
        for (int q = 0; q < 4; ++q) am = fmaxf(am, fmaxf(fmaxf(fabsf(a[q][0]), fabsf(a[q][1])), fmaxf(fabsf(a[q][2]), fabsf(a[q][3]))));
#pragma unroll
        for (int o = 32; o >= 1; o >>= 1) am = fmaxf(am, __shfl_xor(am, o));
        const float inv = am > 0.f ? 127.f / am : 0.f;
#pragma unroll
        for (int q = 0; q < 4; ++q) w[q] = quant4(a[q], inv);
        *(u32x4*)(dU + (((size_t)(L + 1) * 8 + (lane >> 3)) * NEXP + e) * 128 + 16 * (lane & 7)) = w;
        if (lane == 0) us[(size_t)(L + 1) * NEXP + e] = am * (1.f / 127.f);
    }
}
DI void p0_prologue(const Args& a, LAS unsigned char* lds) {
    const int TIDX = mk_tid(), BIDX = mk_bid(), GDIM = mk_grid(); (void)TIDX; (void)BIDX; (void)GDIM;
    const int tid = TIDX, G = GDIM, gtid = BIDX * 512 + tid, gth = G * 512;
    unsigned char* ws = a.ws;
    {
        LAS float* cact = (LAS float*)lds;
        LAS float* red = (LAS float*)(lds + 8192);
        const float* c = a.in[1];
        for (int i = tid; i < 2048; i += 512) { const float v = c[i]; cact[i] = v / (1.f + __expf(-v)); }
        __syncthreads();
        for (int unit = BIDX; unit < 4 * 48; unit += G) {
            const int L = unit / 48, cg0 = (unit % 48) * 128, cq = tid & 31, kg = tid >> 5;
            const float* W = a.in[2] + (size_t)L * 1024 * 6144 + cg0 + 4 * cq;
            f32x4 s0 = {0.f, 0.f, 0.f, 0.f}, s1 = {0.f, 0.f, 0.f, 0.f};
#pragma unroll 8
            for (int k = kg * 64; k < kg * 64 + 64; ++k) {
                const f32x4 w = *(const f32x4*)(W + (size_t)k * 6144);
                s0 += w * cact[k]; s1 += w * cact[1024 + k];
            }
            *(LAS f32x4*)(red + (kg * 2 + 0) * 128 + 4 * cq) = s0; *(LAS f32x4*)(red + (kg * 2 + 1) * 128 + 4 * cq) = s1;
            __syncthreads();
            if (tid < 256) {
                const int cc = tid & 127, bb = tid >> 7; float s = 0.f;
#pragma unroll
                for (int g = 0; g < 16; ++g) s += red[(g * 2 + bb) * 128 + cc];
                ((float*)(ws + WS_MOD))[(L * 2 + bb) * 6144 + cg0 + cc] = s + a.in[3][L * 6144 + cg0 + cc];
            }
            __syncthreads();
        }
    }
    for (int e = 0; e < 2; ++e) {
        transpose_cvt_lds(a.in[6] + (size_t)e * 1024 * 2048, 1024, 2048, (bf16_t*)(ws + WS_WABIN) + (size_t)e * 2048 * 1024, 1024, PermAbIn(), lds, BIDX, G, tid);
        transpose_cvt_lds(a.in[11] + (size_t)e * 1024 * 1024, 512, 1024, (bf16_t*)(ws + WS_WABOUT) + (size_t)e * 1024 * 1024, 1024, PermId(), lds, BIDX, G, tid);
        transpose_cvt_lds(a.in[12] + (size_t)e * 1024 * 3072, 1024, 3072, (bf16_t*)(ws + WS_WCVIN) + (size_t)e * 3072 * 1024, 1024, PermCvIn(), lds, BIDX, G, tid);
        transpose_cvt_lds(a.in[14] + (size_t)e * 1024 * 1024, 1024, 1024, (bf16_t*)(ws + WS_WCVOUT) + (size_t)e * 1024 * 1024, 1024, PermId(), lds, BIDX, G, tid);
    }
    for (int L = 0; L < 4; ++L)
        transpose_cvt_lds(a.in[15] + (size_t)L * 1024 * 2048, 1024, 2048, (bf16_t*)(ws + WS_WPQ) + (size_t)L * 2048 * 1024, 1024, PermId(), lds, BIDX, G, tid);
    for (int it = gtid; it < 2 * 128 * 256; it += gth) {
        const int n4 = it & 255, k4 = (it >> 8) & 127, e = it >> 15, g = k4 >> 5, i0 = (k4 & 31) * 4;
        const float* pw = a.in[9] + ((size_t)(e * 4 + g) * 128 + i0) * 128;
        const float* ps = a.in[10] + e * 512 + g * 128;
        const float* wo = a.in[11] + (size_t)e * 1024 * 1024 + (size_t)(512 + g * 128) * 1024 + 4 * n4;
        f32x4 s[4];
#pragma unroll
        for (int r = 0; r < 4; ++r) s[r] = (f32x4){0.f, 0.f, 0.f, 0.f};
#pragma unroll 4
        for (int c = 0; c < 128; ++c) {
            const f32x4 w = *(const f32x4*)(wo + (size_t)c * 1024) * ps[c];
#pragma unroll
            for (int r = 0; r < 4; ++r) s[r] += w * pw[r * 128 + c];
        }
        bf16_t* dst = (bf16_t*)(ws + WS_WABOUT) + (size_t)e * 1024 * 1024 + (size_t)(4 * n4) * 1024 + 512 + g * 128 + i0;
#pragma unroll
        for (int j = 0; j < 4; ++j) {
            u32x2 o; o.x = pack2(s[0][j], s[1][j]); o.y = pack2(s[2][j], s[3][j]);
            *(u32x2*)(dst + (size_t)j * 1024) = o;
        }
    }
    cvt_u_i8(a.in[18], ws + WS_PU, (float*)(ws + WS_US), NEXP, BIDX * 8 + (tid >> 6), G * 8, tid & 63);
    for (int L = 0; L < 4; ++L) {
        cvt_elems(a.in[16] + (size_t)L * 16384, (bf16_t*)(ws + WS_KEYS) + (size_t)(L * 2 + 0) * 16384, 16384 / 8, gtid, gth);
        cvt_elems(a.in[17] + (size_t)L * 16384, (bf16_t*)(ws + WS_KEYS) + (size_t)(L * 2 + 1) * 16384, 16384 / 8, gtid, gth);
    }
}

template <bool Q8, bool XBF> DI void norm_phase(const void* __restrict__ xv, const float* __restrict__ gain, const float* __restrict__ modsh, bf16_t* __restrict__ H, unsigned char* __restrict__ H8, float* __restrict__ HS) {
    const int TIDX = mk_tid(), BIDX = mk_bid(), GDIM = mk_grid(); (void)TIDX; (void)BIDX; (void)GDIM;
    const int lane = TIDX & 63, nw = GDIM * 8;
    for (int r0 = BIDX * 8 + (TIDX >> 6); r0 < T / 2; r0 += nw) {
        f32x4 v[2][4]; float ss[2];
#pragma unroll
        for (int z = 0; z < 2; ++z) {
            ss[z] = 0.f;
#pragma unroll
            for (int j = 0; j < 4; ++j) {
                const size_t eo = (size_t)(r0 + z * (T / 2)) * 1024 + 4 * lane + 256 * j;
                if (XBF) { const u32x2 w = *(const u32x2*)((const bf16_t*)xv + eo); v[z][j] = (f32x4){bf_lo(w.x), bf_hi(w.x), bf_lo(w.y), bf_hi(w.y)}; }
                else v[z][j] = *(const f32x4*)((const float*)xv + eo);
                ss[z] += v[z][j][0] * v[z][j][0] + v[z][j][1] * v[z][j][1] + v[z][j][2] * v[z][j][2] + v[z][j][3] * v[z][j][3];
            }
        }
#pragma unroll
        for (int o = 32; o >= 1; o >>= 1) { ss[0] += __shfl_xor(ss[0], o); ss[1] += __shfl_xor(ss[1], o); }
#pragma unroll
        for (int z = 0; z < 2; ++z) {
            const int r = r0 + z * (T / 2), b = r >> 14;
            const float rstd = rsqrtf(ss[z] * (1.f / 1024.f) + EPS);
            const float* sh = modsh + b * 6144; const float* sc = sh + 1024;
            float y[4][4]; float am = 0.f;
#pragma unroll
            for (int j = 0; j < 4; ++j) {
                const int k = 4 * lane + 256 * j;
                const f32x4 g = *(const f32x4*)(gain + k), s1 = *(const f32x4*)(sc + k), s0 = *(const f32x4*)(sh + k);
#pragma unroll
                for (int i = 0; i < 4; ++i) { y[j][i] = v[z][j][i] * rstd * g[i] * (1.f + s1[i]) + s0[i]; am = fmaxf(am, fabsf(y[j][i])); }
                u32x2 w; w.x = pack2(y[j][0], y[j][1]); w.y = pack2(y[j][2], y[j][3]);
                *(u32x2*)(H + (size_t)r * 1024 + k) = w;
            }
            if (Q8) {
#pragma unroll
                for (int o = 32; o >= 1; o >>= 1) am = fmaxf(am, __shfl_xor(am, o));
                const float inv = am > 0.f ? 127.f / am : 0.f;
#pragma unroll
                for (int j = 0; j < 4; ++j) {
                    const int k = 4 * lane + 256 * j;
                    const f32x4 yy = {y[j][0], y[j][1], y[j][2], y[j][3]};
                    *(unsigned*)(H8 + ((size_t)(k >> 7) * T + r) * 128 + (k & 127)) = quant4(yy, inv);
                }
                if (lane == 0) HS[r] = am * (1.f / 127.f);
            }
        }
    }
}
#define XB_TMO      128
#define XB_XCNT(j)  (256  + 64 * (j))
#define XB_XSUB(j)  (1280 + 64 * (j))
#define XB_XGEN(j)  (2304 + 64 * (j))
#define XB_TOP      3328
#define XB_TOPGEN   3392
#define XCD_BAR_WORDS 3456
#define XB_SPIN_CAP (1u << 18)

__device__ __forceinline__ unsigned xb_ld(unsigned* p)              { return __hip_atomic_load(p, __ATOMIC_RELAXED, __HIP_MEMORY_SCOPE_AGENT); }
__device__ __forceinline__ unsigned xb_add(unsigned* p, unsigned v) { return __hip_atomic_fetch_add(p, v, __ATOMIC_RELAXED, __HIP_MEMORY_SCOPE_AGENT); }
__device__ __forceinline__ unsigned xb_xcc_id() { return (unsigned)__builtin_amdgcn_s_getreg((3 << 11) | 20) & 0xFu; }
#define XB_SPIN(cond, bar) do { unsigned _sp = 0; while (cond) { __builtin_amdgcn_s_sleep(1); \
    if ((++_sp & 255u) == 0u) { if (xb_ld(&(bar)[XB_TMO])) break; if (_sp > XB_SPIN_CAP) { atomicAdd(&(bar)[XB_TMO], 1u); break; } } } } while (0)

struct XcdBarrier {
    unsigned* bar; unsigned x;
    volatile LAS unsigned* st;
};

__device__ __forceinline__ XcdBarrier xcd_barrier_post(unsigned* bar, volatile LAS unsigned* st) {
    XcdBarrier b; b.bar = bar; b.x = xb_xcc_id(); b.st = st;
    if (threadIdx.x == 0) (void)xb_add(&bar[XB_XCNT(b.x)], 1u);
    return b;
}
__device__ __forceinline__ void xcd_barrier_complete(unsigned* bar, unsigned x, unsigned& nloc, unsigned& nx) {
    const unsigned G = gridDim.x * gridDim.y * gridDim.z;
    unsigned sum, cnt, mine, sp = 0u;
    for (;;) {
        sum = 0u; cnt = 0u; mine = 0u;
#pragma unroll
        for (unsigned j = 0; j < 16; ++j) { const unsigned c = xb_ld(&bar[XB_XCNT(j)]); sum += c; cnt += (c > 0u) ? 1u : 0u; mine = (j == x) ? c : mine; }
        if (sum == G) break;
        __builtin_amdgcn_s_sleep(1);
        if ((++sp & 255u) == 0u) { if (xb_ld(&bar[XB_TMO])) break; if (sp > XB_SPIN_CAP) { atomicAdd(&bar[XB_TMO], 1u); break; } }
    }
    nloc = mine > 0u ? mine : 1u; nx = cnt > 0u ? cnt : 1u;
}

__device__ __forceinline__ void xcd_barrier(const XcdBarrier& b) {
    asm volatile("s_waitcnt vmcnt(0)" ::: "memory");
    __syncthreads();
    if (threadIdx.x == 0) {
        unsigned* bar = b.bar;
        __builtin_amdgcn_s_waitcnt(0);
        unsigned nloc = b.st[0], nx = b.st[1];
        if (nloc == 0u) { xcd_barrier_complete(bar, b.x, nloc, nx); b.st[0] = nloc; b.st[1] = nx; }
        const unsigned old = xb_add(&bar[XB_XSUB(b.x)], 1u);
        const unsigned gen = old / nloc;
        if (old + 1u == (gen + 1u) * nloc) {
            __builtin_amdgcn_fence(__ATOMIC_RELEASE, "agent");
            asm volatile("s_waitcnt vmcnt(0)" ::: "memory");
            const unsigned og = xb_add(&bar[XB_TOP], 1u);
            const unsigned tg = og / nx;
            if (og + 1u == (tg + 1u) * nx) xb_add(&bar[XB_TOPGEN], 1u);
            else XB_SPIN(xb_ld(&bar[XB_TOPGEN]) == tg, bar);
            __builtin_amdgcn_fence(__ATOMIC_ACQUIRE, "agent");
            xb_add(&bar[XB_XGEN(b.x)], 1u);
            asm volatile("s_waitcnt vmcnt(0)" ::: "memory");
        } else {
            XB_SPIN(xb_ld(&bar[XB_XGEN(b.x)]) == gen, bar);
            __builtin_amdgcn_fence(__ATOMIC_ACQUIRE, "agent");
            asm volatile("s_waitcnt vmcnt(0)" ::: "memory");
        }
    }
    __syncthreads();
}

struct EpiQKVU {
    static constexpr bool PERM = true, AFTER_DRAIN = false;
    bf16_t* dst; const float* qgain; const float* kgain;
    DI void operator()(const f32x4 (&acc)[2][2][4][2], const Unit& u, int wr, int wc, int fr, int fq) const {
        const int region = u.pn >> 1, head = 4 * (u.pn & 1) + wc;
        const float* gain = (region == 0 ? qgain : kgain) + head * 64;
        f32x4 gv[2][2];
#pragma unroll
        for (int bj = 0; bj < 2; ++bj)
#pragma unroll
            for (int n = 0; n < 2; ++n) gv[bj][n] = (region < 2) ? *(const f32x4*)(gain + 32 * bj + 8 * fq + 4 * n) : (f32x4){1.f, 1.f, 1.f, 1.f};
#pragma unroll
        for (int ai = 0; ai < 2; ++ai)
#pragma unroll
            for (int m = 0; m < 4; ++m) {
                const int row = u.pm * 256 + ai * 128 + wr * 64 + m * 16 + fr, b = row >> 14, t = row & (SEQ - 1);
                float rs = 1.f;
                if (region < 2) {
                    float ss = 0.f;
#pragma unroll
                    for (int bj = 0; bj < 2; ++bj)
#pragma unroll
                        for (int n = 0; n < 2; ++n) { const f32x4 x = acc[ai][bj][m][n]; ss += (x[0] * x[0] + x[1] * x[1]) + (x[2] * x[2] + x[3] * x[3]); }
                    ss += __shfl_xor(ss, 16); ss += __shfl_xor(ss, 32);
                    rs = rsqrtf(ss * (1.f / 64.f) + EPS);
                }
                bf16_t* p = dst + (size_t)region * ((size_t)T * 512) + ((size_t)(b * 8 + head) * SEQ + t) * 64 + 8 * fq;
#pragma unroll
                for (int bj = 0; bj < 2; ++bj) {
                    const f32x4 v0 = acc[ai][bj][m][0] * gv[bj][0] * rs, v1 = acc[ai][bj][m][1] * gv[bj][1] * rs;
                    u32x4 w; w.x = pack2(v0[0], v0[1]); w.y = pack2(v0[2], v0[3]); w.z = pack2(v1[0], v1[1]); w.w = pack2(v1[2], v1[3]);
                    *(u32x4*)(p + 32 * bj) = w;
                }
            }
    }
};
struct EpiResid {
    static constexpr bool PERM = true, AFTER_DRAIN = false;
    const float* base32; const bf16_t* base16; bf16_t* out; const float* gate;
    DI void operator()(const f32x4 (&acc)[2][2][4][2], const Unit& u, int wr, int wc, int fr, int fq) const {
        const int b = (u.pm * 256) >> 14, col0 = u.pn * 256 + wc * 32 + 8 * fq;
        f32x4 gv[2][2];
#pragma unroll
        for (int bj = 0; bj < 2; ++bj)
#pragma unroll
            for (int n = 0; n < 2; ++n) gv[bj][n] = *(const f32x4*)(gate + b * 6144 + col0 + bj * 128 + 4 * n);
#pragma unroll
        for (int ai = 0; ai < 2; ++ai)
#pragma unroll
            for (int m = 0; m < 4; ++m) {
                const size_t off = (size_t)(u.pm * 256 + ai * 128 + wr * 64 + m * 16 + fr) * 1024 + col0;
#pragma unroll
                for (int bj = 0; bj < 2; ++bj) {
                    f32x4 x0, x1;
                    if (base32) { x0 = *(const f32x4*)(base32 + off + bj * 128); x1 = *(const f32x4*)(base32 + off + bj * 128 + 4); }
                    else { const u32x4 w = *(const u32x4*)(base16 + off + bj * 128); x0 = (f32x4){bf_lo(w.x), bf_hi(w.x), bf_lo(w.y), bf_hi(w.y)}; x1 = (f32x4){bf_lo(w.z), bf_hi(w.z), bf_lo(w.w), bf_hi(w.w)}; }
                    const f32x4 v0 = x0 + gv[bj][0] * acc[ai][bj][m][0], v1 = x1 + gv[bj][1] * acc[ai][bj][m][1];
                    u32x4 o; o.x = pack2(v0[0], v0[1]); o.y = pack2(v0[2], v0[3]); o.z = pack2(v1[0], v1[1]); o.w = pack2(v1[2], v1[3]);
                    *(u32x4*)(out + off + bj * 128) = o;
                }
            }
    }
};
struct EpiConvIn {
    static constexpr bool PERM = true, AFTER_DRAIN = false;
    bf16_t* U; bf16_t* GB;
    DI void operator()(const f32x4 (&acc)[2][2][4][2], const Unit& u, int wr, int wc, int fr, int fq) const {
#pragma unroll
        for (int ai = 0; ai < 2; ++ai)
#pragma unroll
            for (int m = 0; m < 4; ++m) {
                const size_t row = (size_t)(u.pm * 256 + ai * 128 + wr * 64 + m * 16 + fr);
                if (u.pn < 8) {
                    const f32x4 v0 = acc[ai][0][m][0] * acc[ai][1][m][0], v1 = acc[ai][0][m][1] * acc[ai][1][m][1];
                    u32x4 w; w.x = pack2(v0[0], v0[1]); w.y = pack2(v0[2], v0[3]); w.z = pack2(v1[0], v1[1]); w.w = pack2(v1[2], v1[3]);
                    *(u32x4*)(U + row * 1024 + 128 * u.pn + 32 * wc + 8 * fq) = w;
                } else {
#pragma unroll
                    for (int bj = 0; bj < 2; ++bj) {
                        const f32x4 v0 = acc[ai][bj][m][0], v1 = acc[ai][bj][m][1];
                        u32x4 w; w.x = pack2(v0[0], v0[1]); w.y = pack2(v0[2], v0[3]); w.z = pack2(v1[0], v1[1]); w.w = pack2(v1[2], v1[3]);
                        *(u32x4*)(GB + row * 1024 + 256 * (u.pn - 8) + 128 * bj + 32 * wc + 8 * fq) = w;
                    }
                }
            }
    }
};
struct EpiPlain {
    static constexpr bool PERM = true, AFTER_DRAIN = false;
    bf16_t* O; int ldc;
    DI void operator()(const f32x4 (&acc)[2][2][4][2], const Unit& u, int wr, int wc, int fr, int fq) const {
#pragma unroll
        for (int ai = 0; ai < 2; ++ai)
#pragma unroll
            for (int m = 0; m < 4; ++m) {
                bf16_t* p = O + (size_t)(u.pm * 256 + ai * 128 + wr * 64 + m * 16 + fr) * ldc + u.pn * 256 + 32 * wc + 8 * fq;
#pragma unroll
                for (int bj = 0; bj < 2; ++bj) {
                    const f32x4 v0 = acc[ai][bj][m][0], v1 = acc[ai][bj][m][1];
                    u32x4 w; w.x = pack2(v0[0], v0[1]); w.y = pack2(v0[2], v0[3]); w.z = pack2(v1[0], v1[1]); w.w = pack2(v1[2], v1[3]);
                    *(u32x4*)(p + 128 * bj) = w;
                }
            }
    }
};
template <class Epi> DI void run_gemm(LAS unsigned char* lds, const bf16_t* A, const bf16_t* Bt, int N, const Epi& E) {
    const int TIDX = mk_tid(), BIDX = mk_bid(), GDIM = mk_grid(); (void)TIDX; (void)BIDX; (void)GDIM;
    pg8::Gemm g{A, Bt, T, N, 1024}; pg8::StaticOrder S; S.init(T, N, GDIM, (int)BIDX);
    pg8::gemm_phase<Epi, pg8::StaticOrder, true, true>(lds, g, S, E);
}

typedef short s16x4 __attribute__((ext_vector_type(4)));
DI void attn_phase(const bf16_t* __restrict__ Q, const bf16_t* __restrict__ K, const bf16_t* __restrict__ V, bf16_t* __restrict__ ycat, LAS unsigned char* lds) {
    const int TIDX = mk_tid(), BIDX = mk_bid(), GDIM = mk_grid(); (void)TIDX; (void)BIDX; (void)GDIM;
    const int lane = TIDX & 63, wave = __builtin_amdgcn_readfirstlane(TIDX >> 6), lr = lane & 31, h = lane >> 5;
    LAS unsigned char* vl0 = lds + wave * 9216;
    const unsigned trb0 = (unsigned)(size_t)vl0 + (unsigned)((4 * h + ((lane >> 2) & 3)) * 144 + (16 * ((lane >> 4) & 1) + 4 * (lane & 3)) * 2);
    const float NEG = -__builtin_inff();
    const float sc = 0.125f * 1.4426950408889634f;
    const int xj = BIDX & 7, nteam = (GDIM - xj + 7) >> 3, lw = (BIDX >> 3) * 8 + wave, nlw = nteam * 8;
    for (int lp = lw; lp < 512; lp += nlw) {
        const int bh = 2 * xj + (lp >> 8), rest = lp & 255, blk = rest >> 2, r0 = 2 * (rest & 3);
        const size_t base = (size_t)bh * SEQ * 64;
        bf16x8 qf[2][4]; f32x16 o0[2], o1[2]; float mrun[2], lrun[2]; int tq[2];
#pragma unroll
        for (int z = 0; z < 2; ++z) {
            tq[z] = r0 + z + 8 * (blk * 32 + lr);
#pragma unroll
            for (int kk = 0; kk < 4; ++kk) qf[z][kk] = *(const bf16x8*)(Q + base + (size_t)tq[z] * 64 + 16 * kk + 8 * h);
#pragma unroll
            for (int i = 0; i < 16; ++i) { o0[z][i] = 0.f; o1[z][i] = 0.f; }
            mrun[z] = NEG; lrun[z] = 0.f;
        }
#pragma unroll
        for (int br = 0; br < 4; ++br) {
            const int d = br == 0 ? 1 : (br == 1 ? 4 : 16), nkb = br == 0 ? 12 : (br == 1 ? 6 : 5);
            int rho[2], kstart[2], uq[2], lo[2]; unsigned dead;
            dead = (br >= 2 && (lr & 1) != br - 2) ? 0x40000000u : 0u;
#pragma unroll
            for (int z = 0; z < 2; ++z) {
                const int r = r0 + z;
                int u0;
                if (br == 0) { rho[z] = 0; u0 = r + 256 * blk; uq[z] = u0 + 8 * lr; }
                else if (br == 1) { rho[z] = r & 3; u0 = (r >> 2) + 64 * blk; uq[z] = u0 + 2 * lr; }
                else { rho[z] = r + 8 * (br - 2); u0 = 16 * blk; uq[z] = u0 + (lr >> 1); }
                kstart[z] = u0 - 128; lo[z] = uq[z] < 128 ? -uq[z] : -128;
            }
            for (int kb = 0; kb < nkb; ++kb) {
                bf16x8 kf[2][4]; u32x4 vv[2][4];
#pragma unroll
                for (int z = 0; z < 2; ++z) {
                    int kc = kstart[z] + 32 * kb + lr; kc = kc < 0 ? 0 : kc;
                    int pos = rho[z] + d * kc; pos = pos > SEQ - 1 ? SEQ - 1 : pos;
                    const bf16_t* kp = K + base + (size_t)pos * 64; const bf16_t* vp = V + base + (size_t)pos * 64;
#pragma unroll
                    for (int kk = 0; kk < 4; ++kk) kf[z][kk] = *(const bf16x8*)(kp + 16 * kk + 8 * h);
#pragma unroll
                    for (int i = 0; i < 4; ++i) vv[z][i] = *(const u32x4*)(vp + 32 * h + 8 * i);
                }
                asm volatile("" ::: "memory");
#pragma unroll
                for (int z = 0; z < 2; ++z)
#pragma unroll
                    for (int i = 0; i < 4; ++i) *(LAS u32x4*)(vl0 + z * 4608 + lr * 144 + h * 64 + i * 16) = vv[z][i];
                asm volatile("" ::: "memory");
                f32x16 st[2];
#pragma unroll
                for (int z = 0; z < 2; ++z) {
#pragma unroll
                    for (int i = 0; i < 16; ++i) st[z][i] = 0.f;
#pragma unroll
                    for (int kk = 0; kk < 4; ++kk) st[z] = MFMA32(kf[z][kk], qf[z][kk], st[z]);
                }
                float bm[2]; bool raise[2];
#pragma unroll
                for (int z = 0; z < 2; ++z) {
                    const unsigned xb = dead ? 0x40000000u : (unsigned)(kstart[z] + 32 * kb - uq[z] - lo[z] + 4 * h), wl = (unsigned)(-lo[z]);
                    float m = NEG;
#pragma unroll
                    for (int i = 0; i < 16; ++i) {
                        const bool valid = (xb + (unsigned)((i & 3) + 8 * (i >> 2))) <= wl;
                        st[z][i] = valid ? st[z][i] : NEG; m = fmaxf(m, st[z][i]);
                    }
                    bm[z] = m;
                }
#pragma unroll
                for (int z = 0; z < 2; ++z) { bm[z] = fmaxf(bm[z], __shfl_xor(bm[z], 32)) * sc; raise[z] = bm[z] > mrun[z] + 8.f; }
                if (__builtin_amdgcn_ballot_w64(raise[0] || raise[1]) != 0ull) {
#pragma unroll
                    for (int z = 0; z < 2; ++z) {
                        const float mnew = raise[z] ? bm[z] : mrun[z];
                        const float alpha = raise[z] ? __builtin_amdgcn_exp2f(mrun[z] - mnew) : 1.f;
                        lrun[z] *= alpha; mrun[z] = mnew;
#pragma unroll
                        for (int i = 0; i < 16; ++i) { o0[z][i] *= alpha; o1[z][i] *= alpha; }
                    }
                }
                bf16x8 pf0[2], pf1[2];
#pragma unroll
                for (int z = 0; z < 2; ++z) {
                    const float nm = (mrun[z] == NEG) ? 0.f : -mrun[z];
                    float ps = 0.f; float p[16];
#pragma unroll
                    for (int i = 0; i < 16; ++i) { p[i] = __builtin_amdgcn_exp2f(__builtin_fmaf(st[z][i], sc, nm)); ps += p[i]; }
                    lrun[z] += ps;
                    u32x4 pw0, pw1;
                    pw0.x = pack2(p[0], p[1]); pw0.y = pack2(p[2], p[3]); pw0.z = pack2(p[4], p[5]); pw0.w = pack2(p[6], p[7]);
                    pw1.x = pack2(p[8], p[9]); pw1.y = pack2(p[10], p[11]); pw1.z = pack2(p[12], p[13]); pw1.w = pack2(p[14], p[15]);
                    pf0[z] = __builtin_bit_cast(bf16x8, pw0); pf1[z] = __builtin_bit_cast(bf16x8, pw1);
                }
#pragma unroll
                for (int z = 0; z < 2; ++z) {
                    s16x4 t00, t01, t10, t11, t20, t21, t30, t31;
                    asm volatile("ds_read_b64_tr_b16 %0, %8 offset:0\n\tds_read_b64_tr_b16 %1, %8 offset:1152\n\t"
                                 "ds_read_b64_tr_b16 %2, %8 offset:64\n\tds_read_b64_tr_b16 %3, %8 offset:1216\n\t"
                                 "ds_read_b64_tr_b16 %4, %8 offset:2304\n\tds_read_b64_tr_b16 %5, %8 offset:3456\n\t"
                                 "ds_read_b64_tr_b16 %6, %8 offset:2368\n\tds_read_b64_tr_b16 %7, %8 offset:3520\n\t"
                                 "s_waitcnt lgkmcnt(0)"
                                 : "=&v"(t00), "=&v"(t01), "=&v"(t10), "=&v"(t11), "=&v"(t20), "=&v"(t21), "=&v"(t30), "=&v"(t31) : "v"(trb0 + z * 4608) : "memory");
                    const bf16x8 vf00 = __builtin_shufflevector(t00, t01, 0, 1, 2, 3, 4, 5, 6, 7);
                    const bf16x8 vf01 = __builtin_shufflevector(t10, t11, 0, 1, 2, 3, 4, 5, 6, 7);
                    const bf16x8 vf10 = __builtin_shufflevector(t20, t21, 0, 1, 2, 3, 4, 5, 6, 7);
                    const bf16x8 vf11 = __builtin_shufflevector(t30, t31, 0, 1, 2, 3, 4, 5, 6, 7);
                    o0[z] = MFMA32(vf00, pf0[z], o0[z]); o1[z] = MFMA32(vf01, pf0[z], o1[z]);
                    o0[z] = MFMA32(vf10, pf1[z], o0[z]); o1[z] = MFMA32(vf11, pf1[z], o1[z]);
                }
                asm volatile("" ::: "memory");
            }
        }
        const int b = bh >> 3, head = bh & 7;
#pragma unroll
        for (int z = 0; z < 2; ++z) {
            const float ltot = lrun[z] + __shfl_xor(lrun[z], 32), inv = 1.f / ltot;
            bf16_t* op = ycat + ((size_t)b * SEQ + tq[z]) * 1024 + head * 64;
#pragma unroll
            for (int g = 0; g < 4; ++g) {
                u32x2 w0, w1;
                w0.x = pack2(o0[z][4 * g] * inv, o0[z][4 * g + 1] * inv); w0.y = pack2(o0[z][4 * g + 2] * inv, o0[z][4 * g + 3] * inv);
                w1.x = pack2(o1[z][4 * g] * inv, o1[z][4 * g + 1] * inv); w1.y = pack2(o1[z][4 * g + 2] * inv, o1[z][4 * g + 3] * inv);
                *(u32x2*)(op + 8 * g + 4 * h) = w0; *(u32x2*)(op + 32 + 8 * g + 4 * h) = w1;
            }
        }
    }
}
DI void pool_phase(const bf16_t* __restrict__ Uh, bf16_t* __restrict__ ycat) {
    const int TIDX = mk_tid(), BIDX = mk_bid(), GDIM = mk_grid(); (void)TIDX; (void)BIDX; (void)GDIM;
    const int gth = GDIM * 512;
    for (int it = BIDX * 512 + TIDX; it < T * 8 * 8; it += gth) {
        const int ck = it & 7, t = (it >> 3) & (SEQ - 1), bh = it >> 17, h8 = bh & 7, b = bh >> 3;
        const int w = 2 << (h8 >> 1), cnt = (t + 1 < w) ? t + 1 : w;
        const bf16_t* p = Uh + ((size_t)bh * SEQ + t) * 64 + 8 * ck;
        float s[8], u0[8];
#pragma unroll
        for (int i = 0; i < 8; ++i) s[i] = 0.f;
        for (int j = 0; j < cnt; ++j) {
            const u32x4 v = *(const u32x4*)(p - (size_t)j * 64);
            const float f[8] = {bf_lo(v.x), bf_hi(v.x), bf_lo(v.y), bf_hi(v.y), bf_lo(v.z), bf_hi(v.z), bf_lo(v.w), bf_hi(v.w)};
#pragma unroll
            for (int i = 0; i < 8; ++i) { s[i] += f[i]; if (j == 0) u0[i] = f[i]; }
        }
        const float ic = 1.f / (float)cnt;
        u32x4 o; o.x = pack2(s[0] * ic - u0[0], s[1] * ic - u0[1]); o.y = pack2(s[2] * ic - u0[2], s[3] * ic - u0[3]); o.z = pack2(s[4] * ic - u0[4], s[5] * ic - u0[5]); o.w = pack2(s[6] * ic - u0[6], s[7] * ic - u0[7]);
        *(u32x4*)(ycat + ((size_t)b * SEQ + t) * 1024 + 512 + 64 * h8 + 8 * ck) = o;
    }
}
DI void conv_phase(const bf16_t* __restrict__ U, const bf16_t* __restrict__ GB, const float* __restrict__ cw, bf16_t* __restrict__ Z) {
    const int TIDX = mk_tid(), BIDX = mk_bid(), GDIM = mk_grid(); (void)TIDX; (void)BIDX; (void)GDIM;
    const int gth = GDIM * 512;
    for (int it = BIDX * 512 + TIDX; it < T * 128; it += gth) {
        const int ck = it & 127, r = it >> 7, t = r & (SEQ - 1);
        const size_t off = (size_t)r * 1024 + 8 * ck;
        const u32x4 z4 = {0u, 0u, 0u, 0u};
        const u32x4 a0 = *(const u32x4*)(U + off), a1 = t >= 1 ? *(const u32x4*)(U + off - 1024) : z4, a2 = t >= 2 ? *(const u32x4*)(U + off - 2048) : z4, gb = *(const u32x4*)(GB + off);
        const float f0[8] = {bf_lo(a0.x), bf_hi(a0.x), bf_lo(a0.y), bf_hi(a0.y), bf_lo(a0.z), bf_hi(a0.z), bf_lo(a0.w), bf_hi(a0.w)};
        const float f1[8] = {bf_lo(a1.x), bf_hi(a1.x), bf_lo(a1.y), bf_hi(a1.y), bf_lo(a1.z), bf_hi(a1.z), bf_lo(a1.w), bf_hi(a1.w)};
        const float f2[8] = {bf_lo(a2.x), bf_hi(a2.x), bf_lo(a2.y), bf_hi(a2.y), bf_lo(a2.z), bf_hi(a2.z), bf_lo(a2.w), bf_hi(a2.w)};
        const float fg[8] = {bf_lo(gb.x), bf_hi(gb.x), bf_lo(gb.y), bf_hi(gb.y), bf_lo(gb.z), bf_hi(gb.z), bf_lo(gb.w), bf_hi(gb.w)};
        float y[8];
#pragma unroll
        for (int i = 0; i < 8; ++i) { const int c = 8 * ck + i; y[i] = fg[i] * (cw[c] * f0[i] + cw[1024 + c] * f1[i] + cw[2048 + c] * f2[i]); }
        u32x4 o; o.x = pack2(y[0], y[1]); o.y = pack2(y[2], y[3]); o.z = pack2(y[4], y[5]); o.w = pack2(y[6], y[7]);
        *(u32x4*)(Z + off) = o;
    }
}
DI void cmpx(float& a, float& b) { const float mx = fmaxf(a, b), mn = fminf(a, b); a = mx; b = mn; }
DI void cmpx_asc(float& a, float& b) { const float mx = fmaxf(a, b), mn = fminf(a, b); a = mn; b = mx; }
template <int K, int J> struct BitonicStage {
    template <int N> static DI void run(float (&v)[N], int base) {
#pragma unroll
        for (int i = 0; i < 16; ++i) { const int l = i ^ J; if (l > i) { if ((i & K) == 0) cmpx(v[base + i], v[base + l]); else cmpx_asc(v[base + i], v[base + l]); } }
    }
};
template <int N> DI void sort16_desc(float (&v)[N], int base) {
    BitonicStage<2, 1>::run(v, base);
    BitonicStage<4, 2>::run(v, base); BitonicStage<4, 1>::run(v, base);
    BitonicStage<8, 4>::run(v, base); BitonicStage<8, 2>::run(v, base); BitonicStage<8, 1>::run(v, base);
    BitonicStage<16, 8>::run(v, base); BitonicStage<16, 4>::run(v, base); BitonicStage<16, 2>::run(v, base); BitonicStage<16, 1>::run(v, base);
}
DI void merge16_desc(float (&L)[16]) {
#pragma unroll
    for (int st = 8; st >= 1; st >>= 1)
#pragma unroll
        for (int i = 0; i < 16; ++i) if ((i & st) == 0) cmpx(L[i], L[i + st]);
}
DI void top16_of_64(float (&s)[64], float (&top)[16]) {
    sort16_desc(s, 0); sort16_desc(s, 16); sort16_desc(s, 32); sort16_desc(s, 48);
    float A[16], B[16];
#pragma unroll
    for (int i = 0; i < 16; ++i) { A[i] = fmaxf(s[i], s[31 - i]); B[i] = fmaxf(s[32 + i], s[63 - i]); }
    merge16_desc(A); merge16_desc(B);
#pragma unroll
    for (int i = 0; i < 16; ++i) top[i] = fmaxf(A[i], B[15 - i]);
    merge16_desc(top);
}
DI void top16_of_cands(float (&c)[64], float (&top)[16]) {
    sort16_desc(c, 16); sort16_desc(c, 32);
    cmpx(c[48], c[49]);
    float A[16], B[16];
#pragma unroll
    for (int i = 0; i < 16; ++i) { A[i] = fmaxf(c[i], c[31 - i]); B[i] = c[32 + i]; }
    B[15] = fmaxf(B[15], c[48]); B[14] = fmaxf(B[14], c[49]);
    merge16_desc(A); merge16_desc(B);
#pragma unroll
    for (int i = 0; i < 16; ++i) top[i] = fmaxf(A[i], B[15 - i]);
    merge16_desc(top);
}
struct Stair { int a[50], b[50]; constexpr Stair() : a{}, b{} { int c = 0; for (int x = 0; x < 16; ++x) for (int y = 0; y < 16; ++y) if ((x + 1) * (y + 1) <= 16) { a[c] = x; b[c] = y; ++c; } } };
DI void route_qload(bf16x8 (&qf)[8], const bf16_t* __restrict__ qp) {
#pragma unroll
    for (int kk = 0; kk < 8; ++kk) qf[kk] = *(const bf16x8*)(qp + 16 * kk);
}
DI void route_scores(const bf16x8 (&qf)[8], const LAS unsigned char* kl, int lr, int h, float (&s)[64]) {
#pragma unroll
    for (int mb = 0; mb < 4; ++mb) {
        f32x16 c;
#pragma unroll
        for (int i = 0; i < 16; ++i) c[i] = 0.f;
        const LAS unsigned char* kp = kl + (32 * mb + lr) * 272 + 16 * h;
#pragma unroll
        for (int kk = 0; kk < 8; ++kk) c = MFMA32(*(const LAS bf16x8*)(kp + 32 * kk), qf[kk], c);
#pragma unroll
        for (int i = 0; i < 16; ++i) { const unsigned key = 32 * mb + (i & 3) + 8 * (i >> 2) + 4 * h; s[mb * 16 + i] = __uint_as_float((__float_as_uint(c[i]) & ~127u) | key); }
    }
}
DI void route_top(float (&s)[64], float (&out)[16]) {
    float top[16];
    top16_of_64(s, top);
    float L[16];
#pragma unroll
    for (int i = 0; i < 16; ++i) L[i] = __shfl_xor(top[15 - i], 32);
#pragma unroll
    for (int i = 0; i < 16; ++i) L[i] = fmaxf(top[i], L[i]);
    merge16_desc(L);
#pragma unroll
    for (int i = 0; i < 16; ++i) out[i] = L[i];
}
DI void route_phase(const bf16_t* __restrict__ PQ, const bf16_t* __restrict__ KEYS, int* __restrict__ ridx, float* __restrict__ rgate, LAS unsigned char* lds) {
    const int TIDX = mk_tid(), BIDX = mk_bid(), GDIM = mk_grid(); (void)TIDX; (void)BIDX; (void)GDIM;
    const int lane = TIDX & 63, wave = TIDX >> 6, lr = lane & 31, h = lane >> 5, nw = GDIM * 8;
    const float NEG = -__builtin_inff();
    for (int it = TIDX; it < 2 * 128 * 16; it += 512) { const int row = it >> 4, ck = it & 15; *(LAS u32x4*)(lds + row * 272 + ck * 16) = *(const u32x4*)(KEYS + (size_t)row * 128 + ck * 8); }
    if (TIDX < 64) { int c = TIDX, x = 0; for (; x < 16; ++x) { const int cnt = 16 / (x + 1); if (c < cnt) break; c -= cnt; } ((LAS unsigned char*)(lds + 69632))[TIDX] = (unsigned char)((x & 15) | ((c & 15) << 4)); }
    __syncthreads();
    bf16x8 qA[8], qB[8];
    { const int u0 = BIDX * 8 + wave, p0 = (u0 < T * 8 / 32 ? u0 : 0) * 32 + lr; const bf16_t* q0 = PQ + (size_t)(p0 >> 3) * 2048 + (p0 & 7) * 256 + 8 * h; route_qload(qA, q0); }
    for (int unit = BIDX * 8 + wave; unit < T * 8 / 32; unit += nw) {
        const int pair = unit * 32 + lr, tok = pair >> 3, head = pair & 7;
        float vs[2][16];
        const int nunit = (unit + nw < T * 8 / 32) ? unit + nw : unit;
        const int npair = nunit * 32 + lr;
        const bf16_t* qn = PQ + (size_t)(npair >> 3) * 2048 + (npair & 7) * 256 + 8 * h;
        route_qload(qB, PQ + (size_t)tok * 2048 + head * 256 + 8 * h + 128);
        {
            float s[64];
            route_scores(qA, lds, lr, h, s);
            route_qload(qA, qn);
            route_top(s, vs[0]);
        }
        __builtin_amdgcn_sched_barrier(0);
        {
            float s[64];
            route_scores(qB, lds + 128 * 272, lr, h, s);
            route_top(s, vs[1]);
        }
        __builtin_amdgcn_sched_barrier(0);
        float cand[64];
#pragma unroll
        for (int cid = 0; cid < 64; ++cid) {
            constexpr Stair ST{};
            if (cid < 50) { const float sum = vs[0][ST.a[cid]] + vs[1][ST.b[cid]]; cand[cid] = __uint_as_float((__float_as_uint(sum) & ~63u) | (unsigned)cid); }
            else cand[cid] = NEG;
        }
        float tv[16]; int te[16];
        top16_of_cands(cand, tv);
        LAS unsigned* mine = (LAS unsigned*)(lds + 69760 + wave * 4352) + lane * 17;
#pragma unroll
        for (int q = 0; q < 8; ++q) {
            mine[q] = (__float_as_uint(vs[0][2 * q]) & 127u) | ((__float_as_uint(vs[0][2 * q + 1]) & 127u) << 16);
            mine[8 + q] = (__float_as_uint(vs[1][2 * q]) & 127u) | ((__float_as_uint(vs[1][2 * q + 1]) & 127u) << 16);
        }
        asm volatile("s_waitcnt lgkmcnt(0)" ::: "memory");
        const LAS unsigned char* ctab = (const LAS unsigned char*)(lds + 69632);
        const LAS unsigned short* mine16 = (const LAS unsigned short*)mine;
#pragma unroll
        for (int it = 0; it < 16; ++it) {
            const unsigned ab = ctab[__float_as_uint(tv[it]) & 63u];
            te[it] = (int)((((unsigned)mine16[ab & 15u] << 7) | (unsigned)mine16[16 + (ab >> 4)]) << 7);
        }
        asm volatile("" ::: "memory");
        const float m0 = tv[0]; float den = 0.f; float ex[16];
#pragma unroll
        for (int i = 0; i < 16; ++i) { ex[i] = __expf(tv[i] - m0); den += ex[i]; }
        const float inv = 1.f / den;
        {
            int* ip = ridx + (size_t)tok * 128 + head * 16; float* gp = rgate + (size_t)tok * 128 + head * 16;
#pragma unroll
            for (int q = 0; q < 4; ++q) {
                *(int4*)(ip + 4 * q) = make_int4(te[4 * q], te[4 * q + 1], te[4 * q + 2], te[4 * q + 3]);
                *(float4*)(gp + 4 * q) = make_float4(ex[4 * q] * inv, ex[4 * q + 1] * inv, ex[4 * q + 2] * inv, ex[4 * q + 3] * inv);
            }
        }
    }
}
DI float gelu_exact(float x) { return 0.5f * x * (1.f + erff(x * 0.70710678118654752f)); }
typedef const unsigned char* cu8p;
struct Team { int j, wit, nwt; };
DI Team team_of(int bidx, int wave, int G) { Team tm; tm.j = bidx & 7; const int nteam = (G - tm.j + 7) >> 3; tm.wit = (bidx >> 3) * 8 + wave; tm.nwt = nteam * 8; return tm; }
DI void idx_load(int (&e)[16], const int* __restrict__ ridx, int t, int g) {
    const int4* ip = (const int4*)(ridx + (size_t)t * 128 + 16 * g);
#pragma unroll
    for (int q = 0; q < 4; ++q) { const int4 v = ip[q]; e[4 * q] = v.x; e[4 * q + 1] = v.y; e[4 * q + 2] = v.z; e[4 * q + 3] = v.w; }
}
DI void rows_load(u32x4 (&uu)[16], cu8p tabj, const int (&e)[16], unsigned moff) {
#pragma unroll
    for (int i = 0; i < 16; ++i) uu[i] = *(const u32x4*)(tabj + ((unsigned)e[i] | moff));
}
DI void pu_compute(const u32x4 (&uu)[16], const u32x4 hq, int m, int& keep0, int& keep1) {
#pragma unroll
    for (int i = 0; i < 16; ++i) {
        int d = __builtin_amdgcn_sdot4((int)uu[i].x, (int)hq.x, 0, false);
        d = __builtin_amdgcn_sdot4((int)uu[i].y, (int)hq.y, d, false); d = __builtin_amdgcn_sdot4((int)uu[i].z, (int)hq.z, d, false); d = __builtin_amdgcn_sdot4((int)uu[i].w, (int)hq.w, d, false);
        d += __builtin_amdgcn_update_dpp(0, d, 0xB1, 0xf, 0xf, true);
        d += __builtin_amdgcn_update_dpp(0, d, 0x4E, 0xf, 0xf, true);
        d += __builtin_amdgcn_update_dpp(0, d, 0x141, 0xf, 0xf, true);
        if (i < 8) keep0 = (m == i) ? d : keep0; else keep1 = (m == i - 8) ? d : keep1;
    }
}
DI void peer_u_phase(cu8p __restrict__ H8, cu8p __restrict__ PU8, const int* __restrict__ ridx, int* __restrict__ P,
                     const float* __restrict__ tu, const float* __restrict__ tv, unsigned char* __restrict__ dU, unsigned char* __restrict__ dV, float* __restrict__ us, int L) {
    const int TIDX = mk_tid(), BIDX = mk_bid(), GDIM = mk_grid(); (void)TIDX; (void)BIDX; (void)GDIM;
    const int lane = TIDX & 63, g = lane >> 3, m = lane & 7;
    const Team tm = team_of(BIDX, TIDX >> 6, GDIM);
    cu8p tabj = PU8 + (size_t)tm.j * NEXP * 128;
    const unsigned moff = 16u * m;
    cu8p hb = H8 + (size_t)tm.j * T * 128 + 16 * m;
    int* Pj = P + (size_t)tm.j * T * 128 + 16 * g + m;
    u32x4 ua[16], ub[16]; int ea[16], eb[16];
    int t = tm.wit;
    const int n1 = tm.nwt;
#define TCL(x) ((x) < T ? (x) : T - 1)
    idx_load(ea, ridx, TCL(t), g);
    idx_load(eb, ridx, TCL(t + n1), g);
    u32x4 hqa = *(const u32x4*)(hb + (size_t)TCL(t) * 128);
    rows_load(ua, tabj, ea, moff);
    const int njr = (L < 3) ? 2 * NEXP : NEXP, gw = BIDX * 8 + (TIDX >> 6), gnw = GDIM * 8;
    int jr = gw; f32x4 ja[4];
    for (; t < T; t += 2 * n1) {
        const int t1 = t + n1, t2 = t + 2 * n1, t3 = t + 3 * n1;
        rows_load(ub, tabj, eb, moff);
        const u32x4 hqb = *(const u32x4*)(hb + (size_t)TCL(t1) * 128);
        idx_load(ea, ridx, TCL(t2), g);
        const bool j0 = jr < njr; if (j0) cj_issue(ja, tu, tv, L, jr, lane);
        __builtin_amdgcn_sched_barrier(0);
        int k0 = 0, k1 = 0;
        pu_compute(ua, hqa, m, k0, k1);
        Pj[(size_t)t * 128] = k0; Pj[(size_t)t * 128 + 8] = k1;
        if (j0) { cj_finish(ja, dU, dV, us, L, jr, lane); jr += gnw; }
        __builtin_amdgcn_sched_barrier(0);
        rows_load(ua, tabj, ea, moff);
        hqa = *(const u32x4*)(hb + (size_t)TCL(t2) * 128);
        idx_load(eb, ridx, TCL(t3), g);
        const bool j1 = jr < njr; if (j1) cj_issue(ja, tu, tv, L, jr, lane);
        __builtin_amdgcn_sched_barrier(0);
        k0 = 0; k1 = 0;
        pu_compute(ub, hqb, m, k0, k1);
        if (t1 < T) { Pj[(size_t)t1 * 128] = k0; Pj[(size_t)t1 * 128 + 8] = k1; }
        if (j1) { cj_finish(ja, dU, dV, us, L, jr, lane); jr += gnw; }
        __builtin_amdgcn_sched_barrier(0);
    }
    for (; jr < njr; jr += gnw) { cj_issue(ja, tu, tv, L, jr, lane); cj_finish(ja, dU, dV, us, L, jr, lane); }
}
DI void peer_r_phase(const int* __restrict__ P, const int* __restrict__ ridx, const float* __restrict__ rgate, const float* __restrict__ HS, const float* __restrict__ US, float* __restrict__ W) {
    const int TIDX = mk_tid(), BIDX = mk_bid(), GDIM = mk_grid(); (void)TIDX; (void)BIDX; (void)GDIM;
    const int gth = GDIM * 512;
    for (int it = BIDX * 512 + TIDX; it < T * 128; it += gth) {
        int s = 0;
#pragma unroll
        for (int j = 0; j < 8; ++j) s += P[(size_t)j * T * 128 + it];
        const float pre = (float)s * HS[it >> 7] * US[ridx[it] >> 7];
        W[it] = rgate[it] * gelu_exact(pre) * 0.125f;
    }
}
typedef _Float16 h2_t __attribute__((ext_vector_type(2)));
DI void w_load(float (&w)[16], const float* __restrict__ W, int t, int g) {
    const float4* wp = (const float4*)(W + (size_t)t * 128 + 16 * g);
#pragma unroll
    for (int q = 0; q < 4; ++q) { const float4 v = wp[q]; w[4 * q] = v.x; w[4 * q + 1] = v.y; w[4 * q + 2] = v.z; w[4 * q + 3] = v.w; }
}
DI void pv_compute(const u32x4 (&vv)[16], const float (&w)[16], int lane, const bf16_t* xr, bf16_t* xw, float* xf, const float* gg, bool store) {
    h2_t oh[8];
#pragma unroll
    for (int q = 0; q < 8; ++q) oh[q] = (h2_t){(_Float16)0.f, (_Float16)0.f};
#pragma unroll
    for (int i = 0; i < 16; ++i) {
        const _Float16 wh = (_Float16)w[i];
        const h2_t w2 = {wh, wh};
#pragma unroll
        for (int q = 0; q < 4; ++q) {
            oh[2 * q] += w2 * __builtin_amdgcn_cvt_scalef32_pk_f16_fp8(vv[i][q], 1.0f, false);
            oh[2 * q + 1] += w2 * __builtin_amdgcn_cvt_scalef32_pk_f16_fp8(vv[i][q], 1.0f, true);
        }
    }
    f32x2_t o2[8];
#pragma unroll
    for (int q = 0; q < 8; ++q) o2[q] = (f32x2_t){(float)oh[q][0], (float)oh[q][1]};
    f32x2_t q4[4], r2[2], fin;
#pragma unroll
    for (int i = 0; i < 4; ++i)
#pragma unroll
        for (int c = 0; c < 2; ++c) {
            const auto sw = __builtin_amdgcn_permlane32_swap(__float_as_uint(o2[i][c]), __float_as_uint(o2[4 + i][c]), false, false);
            q4[i][c] = __uint_as_float(sw[0]) + __uint_as_float(sw[1]);
        }
#pragma unroll
    for (int i = 0; i < 2; ++i)
#pragma unroll
        for (int c = 0; c < 2; ++c) {
            const auto sw = __builtin_amdgcn_permlane16_swap(__float_as_uint(q4[i][c]), __float_as_uint(q4[2 + i][c]), false, false);
            r2[i][c] = __uint_as_float(sw[0]) + __uint_as_float(sw[1]);
        }
    { const bool b3 = lane & 8; const f32x2_t keep = b3 ? r2[1] : r2[0], send = b3 ? r2[0] : r2[1];
      fin[0] = keep[0] + __int_as_float(__builtin_amdgcn_update_dpp(0, __float_as_int(send[0]), 0x128, 0xf, 0xf, true));
      fin[1] = keep[1] + __int_as_float(__builtin_amdgcn_update_dpp(0, __float_as_int(send[1]), 0x128, 0xf, 0xf, true)); }
    if (store) {
        const unsigned xw2 = *(const unsigned*)xr; const f32x2_t xv = {bf_lo(xw2), bf_hi(xw2)}, gv = *(const f32x2_t*)gg, r = xv + gv * fin;
        if (xw) *(unsigned*)xw = pack2(r[0], r[1]); else *(f32x2_t*)xf = r;
    }
}
DI void peer_v_phase(cu8p __restrict__ PV8, const int* __restrict__ ridx, const float* __restrict__ W, const bf16_t* xin, bf16_t* xout, float* fout, const float* __restrict__ g2) {
    const int TIDX = mk_tid(), BIDX = mk_bid(), GDIM = mk_grid(); (void)TIDX; (void)BIDX; (void)GDIM;
    const int lane = TIDX & 63, g = lane >> 3, m = lane & 7;
    const Team tm = team_of(BIDX, TIDX >> 6, GDIM);
    cu8p tabj = PV8 + (size_t)tm.j * NEXP * 128;
    const unsigned moff = 16u * m;
    const int col = 128 * tm.j + 16 * m + 2 * g;
    u32x4 va[16], vb[16]; int ea[16], eb[16]; float wa[16], wb[16];
    int t = tm.wit;
    const int n1 = tm.nwt;
    idx_load(ea, ridx, TCL(t), g);
    idx_load(eb, ridx, TCL(t + n1), g);
    rows_load(va, tabj, ea, moff); w_load(wa, W, TCL(t), g);
    for (; t < T; t += 2 * n1) {
        const int t1 = t + n1, t1c = TCL(t1), t2 = t + 2 * n1, t3 = t + 3 * n1;
        rows_load(vb, tabj, eb, moff); w_load(wb, W, t1c, g);
        idx_load(ea, ridx, TCL(t2), g);
        __builtin_amdgcn_sched_barrier(0);
        pv_compute(va, wa, lane, xin + (size_t)t * 1024 + col, xout ? xout + (size_t)t * 1024 + col : nullptr, fout + (size_t)t * 1024 + col, g2 + (t >> 14) * 6144 + col, true);
        __builtin_amdgcn_sched_barrier(0);
        rows_load(va, tabj, ea, moff); w_load(wa, W, TCL(t2), g);
        idx_load(eb, ridx, TCL(t3), g);
        __builtin_amdgcn_sched_barrier(0);
        pv_compute(vb, wb, lane, xin + (size_t)t1c * 1024 + col, xout ? xout + (size_t)t1c * 1024 + col : nullptr, fout + (size_t)t1c * 1024 + col, g2 + (t1c >> 14) * 6144 + col, t1 < T);
        __builtin_amdgcn_sched_barrier(0);
    }
}

DI void seam_barrier(unsigned char* ws, LAS unsigned char* lds) {
    XcdBarrier b; b.bar = (unsigned*)(ws + WS_BAR); b.x = xb_xcc_id(); b.st = (volatile LAS unsigned*)(lds + 131072);
    xcd_barrier(b);
}
__global__ void __launch_bounds__(512, 2) fwd(Args a) {
    extern __shared__ __attribute__((aligned(16))) unsigned char lds_raw[];
    LAS unsigned char* lds = (LAS unsigned char*)lds_raw;
    cg::grid_group grid = cg::this_grid();
    const int TIDX0 = mk_tid(), BIDX0 = mk_bid();
    unsigned char* ws = a.ws;
    const float* MOD = (const float*)(ws + WS_MOD);
    bf16_t* Hb = (bf16_t*)(ws + WS_H); bf16_t* BIG = (bf16_t*)(ws + WS_BIG); bf16_t* YC = (bf16_t*)(ws + WS_YCAT);
    int* RI = (int*)(ws + WS_RIDX); float* RG = (float*)(ws + WS_RGATE);
#ifdef PROBE_SYNCS
    for (int i = 0; i < 40; ++i) grid.sync();
#endif
    if (BIDX0 == 0) for (int i = TIDX0; i < XCD_BAR_WORDS; i += 512) ((unsigned*)(ws + WS_BAR))[i] = 0u;
    if (TIDX0 < 4) ((LAS unsigned*)(lds + 131072))[TIDX0] = 0u;
    p0_prologue(a, lds);
    grid.sync();
    (void)xcd_barrier_post((unsigned*)(ws + WS_BAR), (volatile LAS unsigned*)(lds + 131072));
#ifdef PROBE_DUP_P0
    p0_prologue(a, lds);
    seam_barrier(ws, lds);
#endif
    for (int L = 0; L < 4; ++L) {
        bf16_t* XB = (bf16_t*)(ws + WS_XB);
        const float* modL = MOD + (size_t)L * 2 * 6144;
        if (L == 0) norm_phase<false, false>(a.in[0], a.in[4] + L * 1024, modL, Hb, nullptr, nullptr); else norm_phase<false, true>(XB, a.in[4] + L * 1024, modL, Hb, nullptr, nullptr);
        seam_barrier(ws, lds);
        if ((L & 1) == 0) {
            const int e = L >> 1;
            { EpiQKVU E{BIG, a.in[7] + e * 512, a.in[8] + e * 512}; run_gemm(lds, Hb, (const bf16_t*)(ws + WS_WABIN) + (size_t)e * 2048 * 1024, 2048, E); }
            seam_barrier(ws, lds);
            attn_phase(BIG, BIG + (size_t)T * 512, BIG + (size_t)2 * T * 512, YC, lds);
#ifdef PROBE_DUP_ATTN
            seam_barrier(ws, lds);
            attn_phase(BIG, BIG + (size_t)T * 512, BIG + (size_t)2 * T * 512, (bf16_t*)(ws + WS_END), lds);
#endif
            pool_phase(BIG + (size_t)3 * T * 512, YC);
            seam_barrier(ws, lds);
            { EpiResid E{L == 0 ? a.in[0] : nullptr, XB, XB, modL + 2048}; run_gemm(lds, YC, (const bf16_t*)(ws + WS_WABOUT) + (size_t)e * 1024 * 1024, 1024, E); }
        } else {
            const int o = L >> 1;
            { EpiConvIn E{BIG, BIG + (size_t)T * 1024}; run_gemm(lds, Hb, (const bf16_t*)(ws + WS_WCVIN) + (size_t)o * 3072 * 1024, 3072, E); }
            seam_barrier(ws, lds);
            conv_phase(BIG, BIG + (size_t)T * 1024, a.in[13] + (size_t)o * 3072, YC);
            seam_barrier(ws, lds);
            { EpiResid E{L == 0 ? a.in[0] : nullptr, XB, XB, modL + 2048}; run_gemm(lds, YC, (const bf16_t*)(ws + WS_WCVOUT) + (size_t)o * 1024 * 1024, 1024, E); }
        }
        seam_barrier(ws, lds);
        norm_phase<true, true>(XB, a.in[5] + L * 1024, modL + 3072, Hb, ws + WS_H8, (float*)(ws + WS_HS));
        seam_barrier(ws, lds);
        { EpiPlain E{BIG, 2048}; run_gemm(lds, Hb, (const bf16_t*)(ws + WS_WPQ) + (size_t)L * 2048 * 1024, 2048, E); }
        seam_barrier(ws, lds);
        route_phase(BIG, (const bf16_t*)(ws + WS_KEYS) + (size_t)L * 2 * 16384, RI, RG, lds);
        seam_barrier(ws, lds);
        peer_u_phase(ws + WS_H8, (cu8p)(ws + WS_PU) + (size_t)L * 8 * NEXP * 128, RI, (int*)(ws + WS_P), a.in[18], a.in[19], ws + WS_PU, ws + WS_PV, (float*)(ws + WS_US), L);
        seam_barrier(ws, lds);
#ifdef PROBE_DUP_U
        peer_u_phase(ws + WS_H8, (cu8p)(ws + WS_PU) + (size_t)L * 8 * NEXP * 128, RI, (int*)(ws + WS_P), a.in[18], a.in[19], ws + WS_PU, ws + WS_PV, (float*)(ws + WS_US), L);
        seam_barrier(ws, lds);
#endif
        peer_r_phase((const int*)(ws + WS_P), RI, RG, (const float*)(ws + WS_HS), (const float*)(ws + WS_US) + (size_t)L * NEXP, (float*)(ws + WS_W));
        seam_barrier(ws, lds);
#ifdef PROBE_DUP_V
        peer_v_phase((cu8p)(ws + WS_PV) + (size_t)L * 8 * NEXP * 128, RI, (const float*)(ws + WS_W), XB, (bf16_t*)(ws + WS_END2), a.out, modL + 5120);
        seam_barrier(ws, lds);
#endif
        peer_v_phase((cu8p)(ws + WS_PV) + (size_t)L * 8 * NEXP * 128, RI, (const float*)(ws + WS_W), XB, L == 3 ? nullptr : XB, a.out, modL + 5120);
        seam_barrier(ws, lds);
#ifdef PROBE_DUP_ROUTE
        route_phase(BIG, (const bf16_t*)(ws + WS_KEYS) + (size_t)L * 2 * 16384, (int*)(ws + WS_END), (float*)(ws + WS_END + 16 * MiB), lds);
        seam_barrier(ws, lds);
#endif
    }
}

extern "C" void kernel_launch(void* const* d_in, const int* in_sizes, int n_in, void* d_out, int out_size, void* d_ws, size_t ws_size, hipStream_t stream) {
    static int grid = 0;
    if (grid == 0) {
        int dev = 0, cus = 0, per_cu = 0;
        if (n_in != 20 || out_size != T * Dm || ws_size < WS_END2 + 160 * MiB) { fprintf(stderr, "kernel_launch: unexpected shapes (n_in %d out %d ws %zu)\n", n_in, out_size, ws_size); grid = -1; return; }
        if (hipGetDevice(&dev) != hipSuccess || hipDeviceGetAttribute(&cus, hipDeviceAttributeMultiprocessorCount, dev) != hipSuccess) { grid = -1; return; }
        if (hipFuncSetAttribute((const void*)fwd, hipFuncAttributeMaxDynamicSharedMemorySize, LDS_BYTES) != hipSuccess) { fprintf(stderr, "hipFuncSetAttribute failed\n"); grid = -1; return; }
        if (hipOccupancyMaxActiveBlocksPerMultiprocessor(&per_cu, (const void*)fwd, 512, LDS_BYTES) != hipSuccess || per_cu < 1) { fprintf(stderr, "occupancy query: %d blocks/CU\n", per_cu); grid = -1; return; }
        grid = cus - cus % 8;
        if (grid < 8) { fprintf(stderr, "kernel_launch: needs at least 8 CUs\n"); grid = -1; return; }
    }
    if (grid < 0) return;
    Args a{};
    for (int i = 0; i < 20; ++i) a.in[i] = (const float*)d_in[i];
    a.out = (float*)d_out; a.ws = (unsigned char*)d_ws; a.ph_lo = 0; a.ph_hi = 0;
    void* args[] = {&a};
    hipError_t e = hipLaunchCooperativeKernel((const void*)fwd, dim3(grid), dim3(512), args, LDS_BYTES, stream);
    if (e != hipSuccess) fprintf(stderr, "cooperative launch failed: %s (grid %d)\n", hipGetErrorString(e), grid);
}
```
